# Optimizing an MI355X kernel written in HIP

```python
import math
import jax, jax.numpy as jnp
from jax import lax
import numpy as np

D_MODEL = 1024
BATCH = 8
SEQ = 2048
DEPTH = 1
DEC_BATCH = 128
DEC_SEQ = 8
PAST_LEN = 16384
PAGE_SIZE = 128

N_MEM = 256
D_MIX = D_MODEL
D_RET = D_MIX // 2
D_LRU = D_MIX - D_RET
RET_HEADS = 4
RET_HEAD_DIM = D_RET // RET_HEADS
RET_CHUNK = 128
ROPE_BASE = 10000.0
LRU_BLOCKS = 8
LRU_BLOCK_DIM = D_LRU // LRU_BLOCKS
CONV_WIDTH = 4
LRU_C = 8.0
XATTN_HEADS = 4
XATTN_HEAD_DIM = D_MODEL // XATTN_HEADS
D_FF = ((8 * D_MODEL // 3) + 127) // 128 * 128
D_IN = 4 * D_RET + 2 * D_LRU
EPS = 1e-6

kernel_name = 'hybrid_retention_rglru_macaron_decoder'


def rmsnorm(x, g):
    xf = x.astype(jnp.float32)
    y = xf * lax.rsqrt(jnp.mean(xf * xf, axis=-1, keepdims=True) + EPS)
    return (y * g.astype(jnp.float32)).astype(x.dtype)


def swiglu(x, wg, wu, wd):
    return (jax.nn.silu(x @ wg) * (x @ wu)) @ wd


def rotary(x, pos):
    half = x.shape[-1] // 2
    inv = ROPE_BASE ** (-jnp.arange(half, dtype=jnp.float32) / half)
    ang = pos.astype(jnp.float32)[:, None] * inv[None, :]
    cos = jnp.cos(ang)[None, :, None, :]
    sin = jnp.sin(ang)[None, :, None, :]
    x1, x2 = x[..., :half], x[..., half:]
    return jnp.concatenate([x1 * cos - x2 * sin, x1 * sin + x2 * cos], axis=-1)


def retention(q, k, v, s0):
    b, t, h, d = q.shape
    c = t if t <= RET_CHUNK else RET_CHUNK
    n_chunks = t // c
    lg = jnp.log(1.0 - 2.0 ** (-5.0 - jnp.arange(h, dtype=jnp.float32)))
    idx = jnp.arange(c, dtype=jnp.float32)
    diff = idx[:, None] - idx[None, :]
    dmask = jnp.where(diff[None] >= 0, jnp.exp(lg[:, None, None] * jnp.maximum(diff, 0.0)[None]), 0.0)
    q_dec = jnp.exp(lg[None, :] * (idx[:, None] + 1.0))
    k_dec = jnp.exp(lg[None, :] * (c - 1.0 - idx[:, None]))
    chunk_dec = jnp.exp(lg * c)

    def step(s, qkv):
        qc, kc, vc = qkv
        sc = jnp.einsum('bihd,bjhd->bhij', qc, kc) * dmask[None]
        o = jnp.einsum('bhij,bjhe->bihe', sc, vc) + jnp.einsum('bihd,bhde->bihe', qc, s) * q_dec[None, :, :, None]
        s = chunk_dec[None, :, None, None] * s + jnp.einsum('bjhd,bjhe->bhde', kc * k_dec[None, :, :, None], vc)
        return s, o

    to_chunks = lambda a: a.reshape(b, n_chunks, c, h, d).transpose(1, 0, 2, 3, 4)
    s_last, o = lax.scan(step, s0, (to_chunks(q), to_chunks(k), to_chunks(v)))
    o = o.transpose(1, 0, 2, 3, 4).reshape(b, t, h, d)
    return o, s_last


def causal_conv(u, buf, w, bias):
    t = u.shape[1]
    full = jnp.concatenate([buf.astype(u.dtype), u], axis=1)
    out = full[:, 0:t] * w[0]
    for j in range(1, CONV_WIDTH):
        out = out + full[:, j:j + t] * w[j]
    return out + bias, full[:, t:]


def rglru(xc, h0, wa, ba, wx, bx, lam):
    b, t, w = xc.shape
    xb = xc.reshape(b, t, LRU_BLOCKS, LRU_BLOCK_DIM)
    r = jax.nn.sigmoid(jnp.einsum('btnk,nkj->btnj', xb, wa.astype(jnp.float32)).reshape(b, t, w) + ba)
    i = jax.nn.sigmoid(jnp.einsum('btnk,nkj->btnj', xb, wx.astype(jnp.float32)).reshape(b, t, w) + bx)
    log_a = -LRU_C * r * jax.nn.softplus(-lam.astype(jnp.float32))
    a = jnp.exp(log_a)
    gx = jnp.sqrt(-jnp.expm1(2.0 * log_a)) * (i * xc)

    def step(h, ab):
        a_t, g_t = ab
        h = a_t * h + g_t
        return h, h

    h_last, hs = lax.scan(step, h0, (a.transpose(1, 0, 2), gx.transpose(1, 0, 2)))
    return hs.transpose(1, 0, 2), h_last


def mem_kv(mem, wk, wv):
    b, m, _ = mem.shape
    k = (mem @ wk).reshape(b, m, XATTN_HEADS, XATTN_HEAD_DIM)
    v = (mem @ wv).reshape(b, m, XATTN_HEADS, XATTN_HEAD_DIM)
    return k, v


def cross_attn(h, mk, mv, wq, wo):
    b, t, _ = h.shape
    q = (h @ wq).reshape(b, t, XATTN_HEADS, XATTN_HEAD_DIM)
    sc = jnp.einsum('bthd,bmhd->bhtm', q.astype(jnp.float32), mk.astype(jnp.float32)) * (XATTN_HEAD_DIM ** -0.5)
    pr = jax.nn.softmax(sc, axis=-1)
    o = jnp.einsum('bhtm,bmhd->bthd', pr, mv.astype(jnp.float32)).reshape(b, t, D_MODEL)
    return o.astype(h.dtype) @ wo


def layer(x, pos, s0, h0, conv0, mk, mv, p, l):
    b, t, _ = x.shape
    x = x + 0.5 * swiglu(rmsnorm(x, p['ffn1_norm'][l]), p['ffn1_wg'][l], p['ffn1_wu'][l], p['ffn1_wd'][l])
    hn = rmsnorm(x, p['mix_norm'][l])
    z = hn @ p['w_in'][l]
    q, k, v, g = (z[..., j * D_RET:(j + 1) * D_RET] for j in range(4))
    u = z[..., 4 * D_RET:4 * D_RET + D_LRU]
    gate = z[..., 4 * D_RET + D_LRU:]
    hd = (b, t, RET_HEADS, RET_HEAD_DIM)
    qf = rotary(q.reshape(hd).astype(jnp.float32), pos)
    kf = rotary(k.reshape(hd).astype(jnp.float32), pos) * (RET_HEAD_DIM ** -0.5)
    vf = v.reshape(hd).astype(jnp.float32)
    o, s_new = retention(qf, kf, vf, s0.astype(jnp.float32))
    mu = jnp.mean(o, axis=-1, keepdims=True)
    var = jnp.mean((o - mu) ** 2, axis=-1, keepdims=True)
    o = ((o - mu) * lax.rsqrt(var + EPS)).reshape(b, t, D_RET) * p['ret_gn_gain'][l].astype(jnp.float32)
    ret_out = (jax.nn.silu(g.astype(jnp.float32)) * o).astype(x.dtype)
    uc, conv_new = causal_conv(u, conv0, p['conv_w'][l], p['conv_b'][l])
    hs, h_new = rglru(uc.astype(jnp.float32), h0.astype(jnp.float32), p['lru_wa'][l], p['lru_ba'][l],
                      p['lru_wx'][l], p['lru_bx'][l], p['lru_lambda'][l])
    lru_out = (rmsnorm(hs, p['lru_norm'][l]) * jax.nn.gelu(gate.astype(jnp.float32))).astype(x.dtype)
    x = x + jnp.concatenate([ret_out, lru_out], axis=-1) @ p['w_out'][l]
    x = x + cross_attn(rmsnorm(x, p['xattn_norm'][l]), mk, mv, p['xattn_wq'][l], p['xattn_wo'][l])
    x = x + 0.5 * swiglu(rmsnorm(x, p['ffn2_norm'][l]), p['ffn2_wg'][l], p['ffn2_wu'][l], p['ffn2_wd'][l])
    return x, s_new, h_new, conv_new


def setup_inputs(seed: int = 0) -> dict:
    key = jax.random.key(seed)
    ks = jax.random.split(key, 40)
    nrm = lambda k, shape, scale: jax.random.normal(k, shape, jnp.float32) * scale
    gain = lambda k, shape: 1.0 + nrm(k, shape, 0.02)
    L = DEPTH
    u = jax.random.uniform(ks[20], (L, D_LRU), jnp.float32, 0.9, 0.999)
    s = u ** (1.0 / LRU_C)
    return {
        'x_prompt': nrm(ks[0], (BATCH, SEQ, D_MODEL), 1.0),
        'x_sample': nrm(ks[1], (DEC_BATCH, DEC_SEQ, D_MODEL), 1.0),
        'state_ret': nrm(ks[2], (L, DEC_BATCH, RET_HEADS, RET_HEAD_DIM, RET_HEAD_DIM), 0.1),
        'state_lru_h': nrm(ks[3], (L, DEC_BATCH, D_LRU), 0.5),
        'state_lru_conv': nrm(ks[4], (L, DEC_BATCH, CONV_WIDTH - 1, D_LRU), 1.0),
        'cache_mem_k': nrm(ks[5], (L, DEC_BATCH, N_MEM, XATTN_HEADS, XATTN_HEAD_DIM), 1.0),
        'cache_mem_v': nrm(ks[6], (L, DEC_BATCH, N_MEM, XATTN_HEADS, XATTN_HEAD_DIM), 1.0),
        'mem_prompt': nrm(ks[7], (BATCH, N_MEM, D_MODEL), 1.0),
        'ffn1_norm': gain(ks[8], (L, D_MODEL)),
        'ffn1_wg': nrm(ks[9], (L, D_MODEL, D_FF), D_MODEL ** -0.5),
        'ffn1_wu': nrm(ks[10], (L, D_MODEL, D_FF), D_MODEL ** -0.5),
        'ffn1_wd': nrm(ks[11], (L, D_FF, D_MODEL), D_FF ** -0.5),
        'mix_norm': gain(ks[12], (L, D_MODEL)),
        'w_in': nrm(ks[13], (L, D_MODEL, D_IN), D_MODEL ** -0.5),
        'ret_gn_gain': gain(ks[14], (L, D_RET)),
        'conv_w': nrm(ks[15], (L, CONV_WIDTH, D_LRU), CONV_WIDTH ** -0.5),
        'conv_b': nrm(ks[16], (L, D_LRU), 0.02),
        'lru_wa': nrm(ks[17], (L, LRU_BLOCKS, LRU_BLOCK_DIM, LRU_BLOCK_DIM), LRU_BLOCK_DIM ** -0.5),
        'lru_ba': nrm(ks[18], (L, D_LRU), 0.02),
        'lru_wx': nrm(ks[19], (L, LRU_BLOCKS, LRU_BLOCK_DIM, LRU_BLOCK_DIM), LRU_BLOCK_DIM ** -0.5),
        'lru_bx': nrm(ks[21], (L, D_LRU), 0.02),
        'lru_lambda': jnp.log(s) - jnp.log1p(-s),
        'lru_norm': gain(ks[22], (L, D_LRU)),
        'w_out': nrm(ks[23], (L, D_MIX, D_MODEL), D_MIX ** -0.5),
        'xattn_norm': gain(ks[24], (L, D_MODEL)),
        'xattn_wq': nrm(ks[25], (L, D_MODEL, D_MODEL), D_MODEL ** -0.5),
        'xattn_wk': nrm(ks[26], (L, D_MODEL, D_MODEL), D_MODEL ** -0.5),
        'xattn_wv': nrm(ks[27], (L, D_MODEL, D_MODEL), D_MODEL ** -0.5),
        'xattn_wo': nrm(ks[28], (L, D_MODEL, D_MODEL), D_MODEL ** -0.5),
        'ffn2_norm': gain(ks[29], (L, D_MODEL)),
        'ffn2_wg': nrm(ks[30], (L, D_MODEL, D_FF), D_MODEL ** -0.5),
        'ffn2_wu': nrm(ks[31], (L, D_MODEL, D_FF), D_MODEL ** -0.5),
        'ffn2_wd': nrm(ks[32], (L, D_FF, D_MODEL), D_FF ** -0.5),
        'final_norm': gain(ks[33], (D_MODEL,)),
    }


def reference(x_prompt, x_sample, state_ret, state_lru_h, state_lru_conv, cache_mem_k, cache_mem_v, mem_prompt,
              ffn1_norm, ffn1_wg, ffn1_wu, ffn1_wd, mix_norm, w_in, ret_gn_gain, conv_w, conv_b,
              lru_wa, lru_ba, lru_wx, lru_bx, lru_lambda, lru_norm, w_out,
              xattn_norm, xattn_wq, xattn_wk, xattn_wv, xattn_wo,
              ffn2_norm, ffn2_wg, ffn2_wu, ffn2_wd, final_norm):
    p = {'ffn1_norm': ffn1_norm, 'ffn1_wg': ffn1_wg, 'ffn1_wu': ffn1_wu, 'ffn1_wd': ffn1_wd,
         'mix_norm': mix_norm, 'w_in': w_in, 'ret_gn_gain': ret_gn_gain, 'conv_w': conv_w, 'conv_b': conv_b,
         'lru_wa': lru_wa, 'lru_ba': lru_ba, 'lru_wx': lru_wx, 'lru_bx': lru_bx, 'lru_lambda': lru_lambda,
         'lru_norm': lru_norm, 'w_out': w_out, 'xattn_norm': xattn_norm, 'xattn_wq': xattn_wq,
         'xattn_wo': xattn_wo, 'ffn2_norm': ffn2_norm, 'ffn2_wg': ffn2_wg, 'ffn2_wu': ffn2_wu, 'ffn2_wd': ffn2_wd}
    bp, tp, _ = x_prompt.shape
    ts = x_sample.shape[1]
    pos_p = jnp.arange(tp, dtype=jnp.int32)
    pos_s = PAST_LEN + jnp.arange(ts, dtype=jnp.int32)
    s0_p = jnp.zeros((bp, RET_HEADS, RET_HEAD_DIM, RET_HEAD_DIM), jnp.float32)
    h0_p = jnp.zeros((bp, D_LRU), jnp.float32)
    c0_p = jnp.zeros((bp, CONV_WIDTH - 1, D_LRU), x_prompt.dtype)
    yp, ys = x_prompt, x_sample
    p_ret, p_h, p_conv, p_mk, p_mv, s_ret, s_h, s_conv = [], [], [], [], [], [], [], []
    for l in range(DEPTH):
        mk, mv = mem_kv(mem_prompt, xattn_wk[l], xattn_wv[l])
        yp, sp, hp, cp = layer(yp, pos_p, s0_p, h0_p, c0_p, mk, mv, p, l)
        ys, ss, hs, cs = layer(ys, pos_s, state_ret[l], state_lru_h[l], state_lru_conv[l],
                               cache_mem_k[l], cache_mem_v[l], p, l)
        p_ret.append(sp); p_h.append(hp); p_conv.append(cp); p_mk.append(mk); p_mv.append(mv)
        s_ret.append(ss); s_h.append(hs); s_conv.append(cs)
    y_prompt = rmsnorm(yp, final_norm)
    y_sample = rmsnorm(ys, final_norm)
    return (y_prompt, y_sample, jnp.stack(p_ret), jnp.stack(p_h), jnp.stack(p_conv), jnp.stack(p_mk),
            jnp.stack(p_mv), jnp.stack(s_ret), jnp.stack(s_h), jnp.stack(s_conv))
```

```cpp
#include <hip/hip_runtime.h>
#include <cstdio>
#include <cstdint>
namespace nv {
constexpr int DM = 1024, NB = 8, SEQ = 2048, DB = 128, DSEQ = 8, NMEM = 256, DRET = 512, DLRU = 512, RH = 4, RD = 128, DFF = 2816, DIN = 3072;
constexpr int MP = NB * SEQ, MS = DB * DSEQ, MT = MP + MS;
constexpr float EPS = 1e-6f;

__device__ __forceinline__ float sigmoidf_(float x) { return 1.0f / (1.0f + expf(-x)); }
__device__ __forceinline__ float siluf_(float x) { return x * sigmoidf_(x); }
__device__ __forceinline__ float gelu_tanh_(float x) { const float c = 0.7978845608028654f; return 0.5f * x * (1.0f + tanhf(c * (x + 0.044715f * x * x * x))); }
__device__ __forceinline__ float softplusf_(float x) { return (x > 0.f ? x : 0.f) + log1pf(expf(-fabsf(x))); }

__global__ void k_copy_x(const float* xp, const float* xs, float* X, int r0) {
    const int r = r0 + blockIdx.x; const float* src = r < MP ? xp + (size_t)r * DM : xs + (size_t)(r - MP) * DM;
    for (int c = threadIdx.x; c < DM; c += blockDim.x) X[(size_t)r * DM + c] = src[c];
}
__global__ void k_rmsnorm(const float* X, const float* g, float* OUT, int n, int r0) {
    __shared__ float red[256];
    const int r = r0 + blockIdx.x; const float* x = X + (size_t)r * n; float s = 0.f;
    for (int c = threadIdx.x; c < n; c += 256) s += x[c] * x[c];
    red[threadIdx.x] = s; __syncthreads();
    for (int o = 128; o > 0; o >>= 1) { if (threadIdx.x < o) red[threadIdx.x] += red[threadIdx.x + o]; __syncthreads(); }
    const float rs = rsqrtf(red[0] / (float)n + EPS);
    for (int c = threadIdx.x; c < n; c += 256) OUT[(size_t)r * n + c] = x[c] * rs * g[c];
}
__global__ void __launch_bounds__(256) k_gemm(const float* A, int lda, const float* W, float* C, int ldc, int N, int K, int mode, float alpha, int row0) {
    __shared__ float As[16][68]; __shared__ float Ws[16][68];
    const int tid = threadIdx.x, tx = tid & 15, ty = tid >> 4;
    const int m0 = row0 + blockIdx.y * 64, n0 = blockIdx.x * 64;
    float acc[4][4] = {};
    for (int k0 = 0; k0 < K; k0 += 16) {
        { const int m = tid >> 2, k4 = (tid & 3) * 4; const float4 v = *(const float4*)(A + (size_t)(m0 + m) * lda + k0 + k4);
          As[k4 + 0][m] = v.x; As[k4 + 1][m] = v.y; As[k4 + 2][m] = v.z; As[k4 + 3][m] = v.w; }
        { const int k = tid >> 4, n4 = (tid & 15) * 4; const float4 v = *(const float4*)(W + (size_t)(k0 + k) * N + n0 + n4);
          Ws[k][n4 + 0] = v.x; Ws[k][n4 + 1] = v.y; Ws[k][n4 + 2] = v.z; Ws[k][n4 + 3] = v.w; }
        __syncthreads();
#pragma unroll
        for (int k = 0; k < 16; ++k) {
            float a[4], b[4];
#pragma unroll
            for (int i = 0; i < 4; ++i) { a[i] = As[k][ty * 4 + i]; b[i] = Ws[k][tx * 4 + i]; }
#pragma unroll
            for (int i = 0; i < 4; ++i)
#pragma unroll
                for (int j = 0; j < 4; ++j) acc[i][j] += a[i] * b[j];
        }
        __syncthreads();
    }
#pragma unroll
    for (int i = 0; i < 4; ++i)
#pragma unroll
        for (int j = 0; j < 4; ++j) {
            float* c = C + (size_t)(m0 + ty * 4 + i) * ldc + n0 + tx * 4 + j;
            if (mode == 0) *c = acc[i][j]; else if (mode == 1) *c = siluf_(*c) * acc[i][j]; else *c += alpha * acc[i][j];
        }
}
__device__ __forceinline__ void row_info(int r, int& seq, int& t, int& pos) { if (r < MP) { seq = r / SEQ; t = r % SEQ; pos = t; } else { seq = NB + (r - MP) / DSEQ; t = (r - MP) % DSEQ; pos = 16384 + t; } }
__global__ void k_rotary(float* Z, int r0, int nrows) {
    const long idx = (long)blockIdx.x * blockDim.x + threadIdx.x; if (idx >= (long)nrows * 2 * RH * 64) return;
    const int j = idx & 63, h = (idx >> 6) & 3, which = (idx >> 8) & 1; const int r = r0 + (int)(idx >> 9);
    int seq, t, pos; row_info(r, seq, t, pos);
    const float inv = powf(10000.0f, -(float)j / 64.0f); const float ang = (float)pos * inv; const float c = cosf(ang), s = sinf(ang);
    float* p = Z + (size_t)r * DIN + which * DRET + h * RD; const float x1 = p[j], x2 = p[j + 64];
    const float sc = which ? 0.08838834764831845f : 1.0f;
    p[j] = (x1 * c - x2 * s) * sc; p[j + 64] = (x1 * s + x2 * c) * sc;
}
__global__ void __launch_bounds__(256) k_retention(const float* Z, const float* state_ret, float* ORAW, float* out_ret_p, float* out_ret_s, int seq0) {
    __shared__ float qs[128], ks[128], red[2][128];
    const int seq = seq0 + blockIdx.x / RH, h = blockIdx.x % RH, tid = threadIdx.x, e = tid & 127, dh = tid >> 7;
    const float gamma = 1.0f - exp2f(-5.0f - (float)h);
    const bool prompt = seq < NB; const int T = prompt ? SEQ : DSEQ; const int rbase = prompt ? seq * SEQ : MP + (seq - NB) * DSEQ;
    float S[64];
#pragma unroll
    for (int i = 0; i < 64; ++i) S[i] = prompt ? 0.f : state_ret[(((size_t)(seq - NB) * RH + h) * RD + dh * 64 + i) * RD + e];
    for (int t = 0; t < T; ++t) {
        const float* z = Z + (size_t)(rbase + t) * DIN;
        if (tid < 128) qs[tid] = z[h * RD + tid]; else ks[tid - 128] = z[DRET + h * RD + tid - 128];
        __syncthreads();
        const float v = z[2 * DRET + h * RD + e]; float part = 0.f;
#pragma unroll
        for (int i = 0; i < 64; ++i) { S[i] = gamma * S[i] + ks[dh * 64 + i] * v; part += qs[dh * 64 + i] * S[i]; }
        red[dh][e] = part; __syncthreads();
        if (dh == 0) ORAW[(size_t)(rbase + t) * DRET + h * RD + e] = red[0][e] + red[1][e];
        __syncthreads();
    }
    float* so = prompt ? out_ret_p + ((size_t)seq * RH + h) * RD * RD : out_ret_s + ((size_t)(seq - NB) * RH + h) * RD * RD;
#pragma unroll
    for (int i = 0; i < 64; ++i) so[(size_t)(dh * 64 + i) * RD + e] = S[i];
}
__global__ void k_ret_gn(const float* ORAW, const float* Z, const float* gain, float* MIX, int r0) {
    __shared__ float red[128];
    const int r = r0 + blockIdx.x / RH, h = blockIdx.x % RH, e = threadIdx.x;
    const float o = ORAW[(size_t)r * DRET + h * RD + e];
    red[e] = o; __syncthreads(); for (int s = 64; s > 0; s >>= 1) { if (e < s) red[e] += red[e + s]; __syncthreads(); }
    const float mu = red[0] / 128.0f; __syncthreads();
    const float d = o - mu; red[e] = d * d; __syncthreads(); for (int s = 64; s > 0; s >>= 1) { if (e < s) red[e] += red[e + s]; __syncthreads(); }
    const float var = red[0] / 128.0f;
    const float g = Z[(size_t)r * DIN + 3 * DRET + h * RD + e];
    MIX[(size_t)r * DM + h * RD + e] = siluf_(g) * (d * rsqrtf(var + EPS) * gain[h * RD + e]);
}
__global__ void k_lru_gates(const float* Z, const float* conv_state, const float* conv_w, const float* conv_b, const float* wa, const float* ba, const float* wx, const float* bx,
                            const float* lam, float* XC, int r0, int nrows) {
    const long idx = (long)blockIdx.x * blockDim.x + threadIdx.x; if (idx >= (long)nrows * DLRU) return;
    const int ch = idx % DLRU, r = r0 + (int)(idx / DLRU); int seq, t, pos; row_info(r, seq, t, pos);
    float acc = conv_b[ch];
    for (int j = 0; j < 4; ++j) { const int tt = t - 3 + j; float u;
        if (tt >= 0) u = Z[(size_t)(r - t + tt) * DIN + 4 * DRET + ch]; else u = (seq < NB) ? 0.f : conv_state[((size_t)(seq - NB) * 3 + (tt + 3)) * DLRU + ch];
        acc += conv_w[j * DLRU + ch] * u; }
    XC[(size_t)r * DLRU + ch] = acc;
}
__global__ void k_lru_gates2(const float* XC, const float* wa, const float* ba, const float* wx, const float* bx, const float* lam, float* A_, float* GX, int r0, int nrows) {
    const long idx = (long)blockIdx.x * blockDim.x + threadIdx.x; if (idx >= (long)nrows * DLRU) return;
    const int ch = idx % DLRU, r = r0 + (int)(idx / DLRU); const int blk = ch / 64, j = ch % 64;
    float sa = 0.f, sx = 0.f; const float* xr = XC + (size_t)r * DLRU + blk * 64;
    for (int k = 0; k < 64; ++k) { const float x = xr[k]; sa += x * wa[((size_t)blk * 64 + k) * 64 + j]; sx += x * wx[((size_t)blk * 64 + k) * 64 + j]; }
    const float rr = sigmoidf_(sa + ba[ch]), ii = sigmoidf_(sx + bx[ch]);
    const float log_a = -8.0f * rr * softplusf_(-lam[ch]); const float a = expf(log_a);
    A_[(size_t)r * DLRU + ch] = a; GX[(size_t)r * DLRU + ch] = sqrtf(-expm1f(2.0f * log_a)) * (ii * xr[j]);
}
__global__ void k_lru_scan(const float* A_, const float* GX, const float* h0s, float* HS, float* out_h_p, float* out_h_s, int seq0, int nseq) {
    const int idx = blockIdx.x * blockDim.x + threadIdx.x; if (idx >= nseq * DLRU) return;
    const int ch = idx % DLRU, seq = seq0 + idx / DLRU; const bool prompt = seq < NB; const int T = prompt ? SEQ : DSEQ; const int rbase = prompt ? seq * SEQ : MP + (seq - NB) * DSEQ;
    float h = prompt ? 0.f : h0s[(size_t)(seq - NB) * DLRU + ch];
    for (int t = 0; t < T; ++t) { const size_t o = (size_t)(rbase + t) * DLRU + ch; h = A_[o] * h + GX[o]; HS[o] = h; }
    if (prompt) out_h_p[(size_t)seq * DLRU + ch] = h; else out_h_s[(size_t)(seq - NB) * DLRU + ch] = h;
}
__global__ void k_lru_out(const float* HS, const float* Z, const float* gain, float* MIX, float* out_conv_p, float* out_conv_s, int r0) {
    __shared__ float red[256];
    const int r = r0 + blockIdx.x, tid = threadIdx.x; const float* hs = HS + (size_t)r * DLRU;
    const float a = hs[tid], b = hs[tid + 256]; red[tid] = a * a + b * b; __syncthreads();
    for (int s = 128; s > 0; s >>= 1) { if (tid < s) red[tid] += red[tid + s]; __syncthreads(); }
    const float rs = rsqrtf(red[0] / 512.0f + EPS); const float* z = Z + (size_t)r * DIN;
    for (int c = tid; c < DLRU; c += 256) MIX[(size_t)r * DM + DRET + c] = hs[c] * rs * gain[c] * gelu_tanh_(z[4 * DRET + DLRU + c]);
    int seq, t, pos; row_info(r, seq, t, pos); const int T = seq < NB ? SEQ : DSEQ;
    if (t >= T - 3) { float* o = seq < NB ? out_conv_p + ((size_t)seq * 3 + (t - (T - 3))) * DLRU : out_conv_s + ((size_t)(seq - NB) * 3 + (t - (T - 3))) * DLRU;
        for (int c = tid; c < DLRU; c += 256) o[c] = z[4 * DRET + c]; }
}
__global__ void __launch_bounds__(256) k_xattn(const float* Q, const float* mk, const float* mv, const float* ck, const float* cv, float* AO, int r0) {
    __shared__ float qs[256], ps[256], red[256];
    const int r = r0 + blockIdx.x / 4, h = blockIdx.x % 4, tid = threadIdx.x; int seq, t, pos; row_info(r, seq, t, pos);
    const float* Kb = seq < NB ? mk + (size_t)seq * NMEM * 1024 : ck + (size_t)(seq - NB) * NMEM * 1024;
    const float* Vb = seq < NB ? mv + (size_t)seq * NMEM * 1024 : cv + (size_t)(seq - NB) * NMEM * 1024;
    qs[tid] = Q[(size_t)r * DM + h * 256 + tid]; __syncthreads();
    const float* kr = Kb + (size_t)tid * 1024 + h * 256; float s = 0.f;
    for (int d = 0; d < 256; ++d) s += qs[d] * kr[d];
    s *= 0.0625f;
    red[tid] = s; __syncthreads(); for (int o = 128; o > 0; o >>= 1) { if (tid < o) red[tid] = fmaxf(red[tid], red[tid + o]); __syncthreads(); }
    const float mx = red[0]; __syncthreads();
    const float p = expf(s - mx); red[tid] = p; ps[tid] = p; __syncthreads();
    for (int o = 128; o > 0; o >>= 1) { if (tid < o) red[tid] += red[tid + o]; __syncthreads(); }
    const float inv = 1.0f / red[0]; float acc = 0.f;
    for (int m = 0; m < 256; ++m) acc += ps[m] * Vb[(size_t)m * 1024 + h * 256 + tid];
    AO[(size_t)r * DM + h * 256 + tid] = acc * inv;
}

struct Bufs { float *X, *R1, *R2, *R3, *R4; };
static void forward(void* const* d_in, float* out, const Bufs& B, hipStream_t st, int pb0, int npb, int sb0, int nsb) {
    const float* const* in = (const float* const*)d_in;
    const float *x_prompt = in[0], *x_sample = in[1], *state_ret = in[2], *state_lru_h = in[3], *state_lru_conv = in[4], *cache_k = in[5], *cache_v = in[6], *mem_prompt = in[7];
    const float *ffn1_norm = in[8], *ffn1_wg = in[9], *ffn1_wu = in[10], *ffn1_wd = in[11], *mix_norm = in[12], *w_in = in[13], *ret_gn = in[14], *conv_w = in[15], *conv_b = in[16];
    const float *lru_wa = in[17], *lru_ba = in[18], *lru_wx = in[19], *lru_bx = in[20], *lru_lam = in[21], *lru_norm = in[22], *w_out = in[23];
    const float *xattn_norm = in[24], *xattn_wq = in[25], *xattn_wk = in[26], *xattn_wv = in[27], *xattn_wo = in[28], *ffn2_norm = in[29], *ffn2_wg = in[30], *ffn2_wu = in[31], *ffn2_wd = in[32], *final_norm = in[33];
    float* o_y = out; float* o_retp = out + 17825792; float* o_hp = o_retp + 524288; float* o_convp = o_hp + 4096; float* o_mk = o_convp + 12288; float* o_mv = o_mk + 2097152;
    float* o_rets = o_mv + 2097152; float* o_hs = o_rets + 8388608; float* o_convs = o_hs + 65536;
    for (int part = 0; part < 2; ++part) {
        const int r0 = part == 0 ? pb0 * SEQ : MP + sb0 * DSEQ, nr = part == 0 ? npb * SEQ : nsb * DSEQ; if (nr == 0) continue;
        const int seq0 = part == 0 ? pb0 : NB + sb0, nseq = part == 0 ? npb : nsb;
        const dim3 gy(1, nr / 64);
        auto gemm = [&](const float* A, int lda, const float* W, float* C, int ldc, int N, int K, int mode, float alpha) {
            hipLaunchKernelGGL(k_gemm, dim3(N / 64, nr / 64), dim3(256), 0, st, A, lda, W, C, ldc, N, K, mode, alpha, r0); };
        hipLaunchKernelGGL(k_copy_x, dim3(nr), dim3(256), 0, st, x_prompt, x_sample, B.X, r0);
        hipLaunchKernelGGL(k_rmsnorm, dim3(nr), dim3(256), 0, st, B.X, ffn1_norm, B.R1, DM, r0);
        gemm(B.R1, DM, ffn1_wg, B.R2, DFF, DFF, DM, 0, 0.f); gemm(B.R1, DM, ffn1_wu, B.R2, DFF, DFF, DM, 1, 0.f); gemm(B.R2, DFF, ffn1_wd, B.X, DM, DM, DFF, 2, 0.5f);
        hipLaunchKernelGGL(k_rmsnorm, dim3(nr), dim3(256), 0, st, B.X, mix_norm, B.R1, DM, r0);
        gemm(B.R1, DM, w_in, B.R2, DIN, DIN, DM, 0, 0.f);
        { const long n = (long)nr * 512; hipLaunchKernelGGL(k_rotary, dim3((unsigned)((n + 255) / 256)), dim3(256), 0, st, B.R2, r0, nr); }
        hipLaunchKernelGGL(k_retention, dim3(nseq * RH), dim3(256), 0, st, B.R2, state_ret, B.R4, o_retp, o_rets, seq0);
        hipLaunchKernelGGL(k_ret_gn, dim3(nr * RH), dim3(128), 0, st, B.R4, B.R2, ret_gn, B.R3, r0);
        { const long n = (long)nr * DLRU; float* XC = B.R4; float* A_ = B.R4 + (size_t)MT * DLRU; float* GX = B.R1; float* HS = B.R1 + (size_t)MT * DLRU;
          hipLaunchKernelGGL(k_lru_gates, dim3((unsigned)((n + 255) / 256)), dim3(256), 0, st, B.R2, state_lru_conv, conv_w, conv_b, lru_wa, lru_ba, lru_wx, lru_bx, lru_lam, XC, r0, nr);
          hipLaunchKernelGGL(k_lru_gates2, dim3((unsigned)((n + 255) / 256)), dim3(256), 0, st, XC, lru_wa, lru_ba, lru_wx, lru_bx, lru_lam, A_, GX, r0, nr);
          hipLaunchKernelGGL(k_lru_scan, dim3((nseq * DLRU + 255) / 256), dim3(256), 0, st, A_, GX, state_lru_h, HS, o_hp, o_hs, seq0, nseq);
          hipLaunchKernelGGL(k_lru_out, dim3(nr), dim3(256), 0, st, HS, B.R2, lru_norm, B.R3, o_convp, o_convs, r0); }
        gemm(B.R3, DM, w_out, B.X, DM, DM, DM, 2, 1.0f);
        if (part == 0) {
            hipLaunchKernelGGL(k_gemm, dim3(DM / 64, npb * NMEM / 64), dim3(256), 0, st, mem_prompt, DM, xattn_wk, o_mk, DM, DM, DM, 0, 0.f, pb0 * NMEM);
            hipLaunchKernelGGL(k_gemm, dim3(DM / 64, npb * NMEM / 64), dim3(256), 0, st, mem_prompt, DM, xattn_wv, o_mv, DM, DM, DM, 0, 0.f, pb0 * NMEM);
        }
        hipLaunchKernelGGL(k_rmsnorm, dim3(nr), dim3(256), 0, st, B.X, xattn_norm, B.R1, DM, r0);
        gemm(B.R1, DM, xattn_wq, B.R4, DM, DM, DM, 0, 0.f);
        hipLaunchKernelGGL(k_xattn, dim3(nr * 4), dim3(256), 0, st, B.R4, o_mk, o_mv, cache_k, cache_v, B.R3, r0);
        gemm(B.R3, DM, xattn_wo, B.X, DM, DM, DM, 2, 1.0f);
        hipLaunchKernelGGL(k_rmsnorm, dim3(nr), dim3(256), 0, st, B.X, ffn2_norm, B.R1, DM, r0);
        gemm(B.R1, DM, ffn2_wg, B.R2, DFF, DFF, DM, 0, 0.f); gemm(B.R1, DM, ffn2_wu, B.R2, DFF, DFF, DM, 1, 0.f); gemm(B.R2, DFF, ffn2_wd, B.X, DM, DM, DFF, 2, 0.5f);
        hipLaunchKernelGGL(k_rmsnorm, dim3(nr), dim3(256), 0, st, B.X, final_norm, o_y, DM, r0);
        (void)gy;
    }
}
}
extern "C" void kernel_launch(void* const* d_in, const int* in_sizes, int n_in, void* d_out, int out_size, void* d_ws, size_t ws_size, hipStream_t stream) {
    const size_t RB = (size_t)nv::MT * 1024 * 4;
    if (n_in != 34 || ws_size < 4 * RB + 3 * RB) { fprintf(stderr, "kernel_launch: unexpected n_in %d or ws_size %zu\n", n_in, ws_size); return; }
    unsigned char* ws = (unsigned char*)d_ws;
    nv::Bufs B; B.X = (float*)ws; B.R1 = (float*)(ws + RB); B.R2 = (float*)(ws + 2 * RB); B.R3 = (float*)(ws + 5 * RB); B.R4 = (float*)(ws + 6 * RB);
    nv::forward(d_in, (float*)d_out, B, stream, 0, 8, 0, 128);
}
```

```cpp
#include <hip/hip_runtime.h>
#include <cstdio>
#include <cstdint>

namespace pg8 {
#define PG8_LAS __attribute__((address_space(3)))
typedef unsigned short bf16_t;
typedef short bf16x8 __attribute__((ext_vector_type(8)));
typedef float f32x4 __attribute__((ext_vector_type(4)));
typedef unsigned u32x4 __attribute__((ext_vector_type(4)));
constexpr int BM = 256, BK = 64, HALF = 128, HTB = HALF * BK * 2  , STAGE_BYTES = 8 * HTB, NXCD = 8, WGM = 8;

__host__ __device__ __forceinline__ int lds_byte(int r, int c) { const int st = (r >> 4) * 2 + (c >> 5), rr = r & 15, cc = c & 31, ob = rr * 64 + cc * 2; return st * 1024 + (ob ^ (((ob >> 9) & 1) << 5)); }
__host__ __device__ __forceinline__ void stage_rc(int b, int& R, int& C) { const int st = b / 1024, sb = b % 1024, swz = sb ^ (((sb >> 9) & 1) << 5); R = (st >> 1) * 16 + swz / 64; C = (st & 1) * 32 + (swz % 64) / 2; }
__host__ __device__ __forceinline__ int perm32(int rho) { const int n = rho >> 4, i = rho & 15; return 8 * (i >> 2) + 4 * n + (i & 3); }

struct Unit { int pm, pn; };
struct Gemm { const bf16_t* A; const bf16_t* Bt; int M, N, K; };

struct StaticOrder {
    int nM, nN, nwg, G, c;
    __host__ __device__ void init(int M, int N, int G_, int c_) { nM = M / BM; nN = N / BM; nwg = nM * nN; G = G_; c = c_; }
    __host__ __device__ bool next(int i, Unit& u) const {
        const long L = (long)i * G + c; if (L >= nwg) return false;
        int wgid = (int)L; { const int q = nwg / NXCD, r = nwg % NXCD, xcd = wgid % NXCD, off = wgid / NXCD; wgid = (xcd < r ? xcd * (q + 1) : r * (q + 1) + (xcd - r) * q) + off; }
        const int nig = WGM * nN, gid = wgid / nig, fm = gid * WGM, gsz = (nM - fm) < WGM ? (nM - fm) : WGM;
        u.pm = fm + ((wgid % nig) % gsz); u.pn = (wgid % nig) / gsz; return true;
    }
    __device__ __forceinline__ void a_ready(const Unit&) const {}
    __device__ __forceinline__ void done(const Unit&) const {}
};


__device__ __forceinline__ unsigned cvt_pk_bf16(float lo, float hi) { unsigned r; asm volatile("v_cvt_pk_bf16_f32 %0, %1, %2" : "=v"(r) : "v"(lo), "v"(hi)); return r; }
typedef float f32x2 __attribute__((ext_vector_type(2)));

template <class Epi, class Sched, bool ALIGN_EPI = false, bool SP2 = false>
__device__ __forceinline__ void gemm_phase(PG8_LAS unsigned char* lds, const Gemm g, const Sched& S, const Epi& E) {
    const int tid = threadIdx.x, wid = __builtin_amdgcn_readfirstlane(tid >> 6), lane = tid & 63, wr = wid >> 2, wc = wid & 3, fr = lane & 15, fq = lane >> 4;
    const int K = g.K, nt = K / BK;
    unsigned voffA[2], voffB[2];
#pragma unroll
    for (int i = 0; i < 2; ++i) { int R, C; stage_rc(tid * 16 + i * 8192, R, C); const int Rb = Epi::PERM ? ((R & ~31) + perm32(R & 31)) : R;
        voffA[i] = (unsigned)(R * K + C) * 2u; voffB[i] = (unsigned)(Rb * K + C) * 2u; }
    const size_t kstep = (size_t)(BK * 2);
    const size_t hstep = (size_t)HALF * K * 2;
    const size_t tstep = 2 * hstep;
    const unsigned ldsw = (unsigned)wid * 1024u;
    const int aoff = lds_byte(wr * 64 + fr, fq * 8), boff = lds_byte(wc * 32 + fr, fq * 8);
#define PG8_SA(b, h) (((b) * 2 + (h)) * HTB)
#define PG8_SB(b, h) ((4 + (b) * 2 + (h)) * HTB)
#define PG8_STAGE(bufoff, gbase, voff) do { _Pragma("unroll") for (int _i = 0; _i < 2; ++_i) \
        __builtin_amdgcn_global_load_lds((const unsigned*)((const char*)(gbase) + (voff)[_i]), (PG8_LAS unsigned*)(lds + (bufoff) + ldsw + _i * 8192), 16, 0, 0); } while (0)
#define PG8_LDA(dst, b, h) do { _Pragma("unroll") for (int m = 0; m < 4; ++m) _Pragma("unroll") for (int k = 0; k < 2; ++k) dst[m][k] = *(const PG8_LAS bf16x8*)(lds + PG8_SA(b, h) + aoff + m * 2048 + k * 1024); } while (0)
#define PG8_LDB(dst, b, h) do { _Pragma("unroll") for (int n = 0; n < 2; ++n) _Pragma("unroll") for (int k = 0; k < 2; ++k) dst[n][k] = *(const PG8_LAS bf16x8*)(lds + PG8_SB(b, h) + boff + n * 2048 + k * 1024); } while (0)
#define PG8_MMA(ai, bj, At, Bt) do { __builtin_amdgcn_s_setprio(1); _Pragma("unroll") for (int m = 0; m < 4; ++m) _Pragma("unroll") for (int n = 0; n < 2; ++n) _Pragma("unroll") for (int k = 0; k < 2; ++k) \
        acc[ai][bj][m][n] = __builtin_amdgcn_mfma_f32_16x16x32_bf16(Bt[n][k], At[m][k], acc[ai][bj][m][n], 0, 0, 0); __builtin_amdgcn_s_setprio(0); } while (0)
#define PG8_WAIT_V(n) asm volatile("s_waitcnt vmcnt(" #n ")" ::: "memory")
#define PG8_WAIT_L(n) asm volatile("s_waitcnt lgkmcnt(" #n ")" ::: "memory")
#define PG8_BAR __builtin_amdgcn_s_barrier()
#define PG8_SCHED __builtin_amdgcn_sched_barrier(0)
    Unit cur, nxt; int ui = 0;
    if (!S.next(0, cur)) return;
    f32x4 acc[2][2][4][2];
#pragma unroll
    for (int a = 0; a < 2; ++a)
#pragma unroll
        for (int b = 0; b < 2; ++b)
#pragma unroll
            for (int m = 0; m < 4; ++m)
#pragma unroll
                for (int n = 0; n < 2; ++n) acc[a][b][m][n] = (f32x4){0.f, 0.f, 0.f, 0.f};
    bf16x8 At[4][2], B0[2][2], B1[2][2];
    const char* cA = (const char*)g.A + (size_t)cur.pm * tstep; const char* cB = (const char*)g.Bt + (size_t)cur.pn * tstep;
    S.a_ready(cur);
    if constexpr (SP2) {
        PG8_STAGE(PG8_SB(0, 0), cB, voffB); PG8_STAGE(PG8_SB(0, 1), cB + hstep, voffB); PG8_STAGE(PG8_SA(0, 0), cA, voffA); PG8_STAGE(PG8_SA(0, 1), cA + hstep, voffA);
        if (wr == 1) PG8_BAR;
        PG8_WAIT_V(2); PG8_BAR;
        PG8_STAGE(PG8_SB(1, 0), cB + kstep, voffB); PG8_STAGE(PG8_SA(1, 0), cA + kstep, voffA); PG8_STAGE(PG8_SB(1, 1), cB + hstep + kstep, voffB);
        PG8_WAIT_V(6); PG8_BAR;
    } else {
        PG8_STAGE(PG8_SB(0, 0), cB, voffB); PG8_STAGE(PG8_SA(0, 0), cA, voffA); PG8_STAGE(PG8_SB(0, 1), cB + hstep, voffB); PG8_STAGE(PG8_SA(0, 1), cA + hstep, voffA);
        if (wr == 1) PG8_BAR;
        PG8_WAIT_V(4); PG8_BAR;
        PG8_STAGE(PG8_SB(1, 0), cB + kstep, voffB); PG8_STAGE(PG8_SA(1, 0), cA + kstep, voffA); PG8_STAGE(PG8_SB(1, 1), cB + hstep + kstep, voffB);
        PG8_WAIT_V(6); PG8_BAR;
    }
    for (;;) {
        const bool has_next = S.next(ui + 1, nxt);
        const char* nA = has_next ? (const char*)g.A + (size_t)nxt.pm * tstep : cA; const char* nB = has_next ? (const char*)g.Bt + (size_t)nxt.pn * tstep : cB;
        for (int t = 0; t < nt; t += 2) {
            const bool last = (t == nt - 2);
            const char* a1 = cA + (size_t)(t + 1) * kstep;
            const char* a2 = last ? nA : cA + (size_t)(t + 2) * kstep; const char* b2 = last ? nB : cB + (size_t)(t + 2) * kstep;
            const char* a3 = a2 + kstep; const char* b3 = b2 + kstep;
            if (last && has_next) S.a_ready(nxt);
            if constexpr (SP2) {
            PG8_LDB(B0, 0, 0); PG8_LDB(B1, 0, 1); PG8_SCHED; PG8_LDA(At, 0, 0); PG8_STAGE(PG8_SA(1, 1), a1 + hstep, voffA);
            PG8_WAIT_V(8); PG8_WAIT_L(0); PG8_BAR; PG8_MMA(0, 0, At, B0); PG8_MMA(0, 1, At, B1); PG8_BAR; PG8_SCHED;
            PG8_LDA(At, 0, 1); PG8_STAGE(PG8_SB(0, 0), b2, voffB); PG8_STAGE(PG8_SB(0, 1), b2 + hstep, voffB); PG8_STAGE(PG8_SA(0, 0), a2, voffA);
            PG8_WAIT_V(8); PG8_WAIT_L(0); PG8_BAR; PG8_MMA(1, 0, At, B0); PG8_MMA(1, 1, At, B1); PG8_BAR; PG8_SCHED;
            PG8_LDB(B0, 1, 0); PG8_LDB(B1, 1, 1); PG8_SCHED; PG8_LDA(At, 1, 0); PG8_STAGE(PG8_SA(0, 1), a2 + hstep, voffA);
            PG8_WAIT_V(8); PG8_WAIT_L(0); PG8_BAR; PG8_MMA(0, 0, At, B0); PG8_MMA(0, 1, At, B1); PG8_BAR; PG8_SCHED;
            PG8_LDA(At, 1, 1); PG8_STAGE(PG8_SB(1, 0), b3, voffB); PG8_STAGE(PG8_SB(1, 1), b3 + hstep, voffB); PG8_STAGE(PG8_SA(1, 0), a3, voffA);
            PG8_WAIT_V(8); PG8_WAIT_L(0); PG8_BAR; PG8_MMA(1, 0, At, B0); PG8_MMA(1, 1, At, B1); PG8_BAR; PG8_SCHED;
            } else {
            PG8_LDB(B0, 0, 0); PG8_SCHED; PG8_LDA(At, 0, 0); PG8_STAGE(PG8_SA(1, 1), a1 + hstep, voffA);
            PG8_WAIT_L(8); PG8_BAR; PG8_WAIT_L(0); PG8_MMA(0, 0, At, B0); PG8_BAR; PG8_SCHED;
            PG8_LDB(B1, 0, 1); PG8_STAGE(PG8_SB(0, 0), b2, voffB);
            PG8_BAR; PG8_WAIT_L(0); PG8_MMA(0, 1, At, B1); PG8_BAR;
            PG8_LDA(At, 0, 1); PG8_STAGE(PG8_SA(0, 0), a2, voffA);
            PG8_BAR; PG8_WAIT_L(0); PG8_MMA(1, 0, At, B0); PG8_BAR; PG8_SCHED;
            PG8_STAGE(PG8_SB(0, 1), b2 + hstep, voffB);
            PG8_WAIT_V(6); PG8_BAR; PG8_MMA(1, 1, At, B1); PG8_BAR;
            PG8_LDB(B0, 1, 0); PG8_SCHED; PG8_LDA(At, 1, 0); PG8_STAGE(PG8_SA(0, 1), a2 + hstep, voffA);
            PG8_WAIT_L(8); PG8_BAR; PG8_WAIT_L(0); PG8_MMA(0, 0, At, B0); PG8_BAR; PG8_SCHED;
            PG8_LDB(B1, 1, 1); PG8_STAGE(PG8_SB(1, 0), b3, voffB);
            PG8_BAR; PG8_WAIT_L(0); PG8_MMA(0, 1, At, B1); PG8_BAR;
            PG8_LDA(At, 1, 1); PG8_STAGE(PG8_SA(1, 0), a3, voffA);
            PG8_BAR; PG8_WAIT_L(0); PG8_MMA(1, 0, At, B0); PG8_BAR; PG8_SCHED;
            PG8_STAGE(PG8_SB(1, 1), b3 + hstep, voffB);
            PG8_WAIT_V(6); PG8_BAR; PG8_MMA(1, 1, At, B1); PG8_BAR;
            }
        }
        if constexpr (ALIGN_EPI) { if (wr == 0) PG8_BAR; }
        if constexpr (!Epi::AFTER_DRAIN) { E(acc, cur, wr, wc, fr, fq); S.done(cur); }
        if (!has_next) break;
#pragma unroll
        for (int a = 0; a < 2; ++a)
#pragma unroll
            for (int b = 0; b < 2; ++b)
#pragma unroll
                for (int m = 0; m < 4; ++m)
#pragma unroll
                    for (int n = 0; n < 2; ++n) acc[a][b][m][n] = (f32x4){0.f, 0.f, 0.f, 0.f};
        cur = nxt; cA = nA; cB = nB; ++ui;
        if constexpr (ALIGN_EPI) { if (wr == 1) PG8_BAR; }
    }
    PG8_WAIT_V(0);
    if constexpr (!ALIGN_EPI) { if (wr == 0) PG8_BAR; }
    PG8_BAR;
    if constexpr (Epi::AFTER_DRAIN) { E.fused(acc, cur, wr, wc, fr, fq, lds, wid, lane); S.done(cur); }
#undef PG8_SA
#undef PG8_SB
#undef PG8_STAGE
#undef PG8_LDA
#undef PG8_LDB
#undef PG8_MMA
#undef PG8_WAIT_V
#undef PG8_WAIT_L
#undef PG8_BAR
#undef PG8_SCHED
}
}

namespace pg8 {
typedef unsigned u32x2 __attribute__((ext_vector_type(2)));
constexpr float LOG2E = 1.4426950408889634f;
__device__ __forceinline__ float fast_sigmoid(float x) { return __builtin_amdgcn_rcpf(1.0f + __builtin_amdgcn_exp2f(-x * LOG2E)); }
__device__ __forceinline__ float fast_silu(float x) { return x * fast_sigmoid(x); }
__device__ __forceinline__ float fast_gelu_tanh(float x) { const float y = 0.7978845608028654f * (x + 0.044715f * x * x * x); return x * fast_sigmoid(2.0f * y); }
__device__ __forceinline__ float rstd_of(const float* ssq, int row) { return rsqrtf(ssq[row] * (1.0f / 1024.0f) + 1e-6f); }

struct EpiSwiglu {
    static constexpr bool PERM = true, AFTER_DRAIN = false;
    bf16_t* H; int ldh; const float* ssq;
    __device__ __forceinline__ void operator()(const f32x4 (&acc)[2][2][4][2], const Unit& u, int wr, int wc, int fr, int fq) const {
        const int row0 = u.pm * BM + wr * 64 + fr; const int col0 = u.pn * HALF + wc * 32 + 8 * fq;
#pragma unroll
        for (int ai = 0; ai < 2; ++ai)
#pragma unroll
            for (int m = 0; m < 4; ++m) { const int row = row0 + ai * HALF + m * 16; const float rs = rstd_of(ssq, row);
                float h[8];
#pragma unroll
                for (int n = 0; n < 2; ++n)
#pragma unroll
                    for (int e = 0; e < 4; ++e) { const float g = acc[ai][0][m][n][e] * rs, uu = acc[ai][1][m][n][e] * rs; h[4 * n + e] = fast_silu(g) * uu; }
                u32x4 w; w.x = cvt_pk_bf16(h[0], h[1]); w.y = cvt_pk_bf16(h[2], h[3]); w.z = cvt_pk_bf16(h[4], h[5]); w.w = cvt_pk_bf16(h[6], h[7]);
                *(u32x4*)(H + (size_t)row * ldh + col0) = w; }
    }
};
struct EpiResid {
    static constexpr bool PERM = false, AFTER_DRAIN = false;
    const float* base_p; const float* base_s; float* out; bf16_t* XB; float* ssq; float alpha;
    __device__ __forceinline__ void operator()(const f32x4 (&acc)[2][2][4][2], const Unit& u, int wr, int wc, int fr, int fq) const {
        const int row0 = u.pm * BM + wr * 64 + fr, col0 = u.pn * BM + wc * 32 + 4 * fq;
#pragma unroll
        for (int ai = 0; ai < 2; ++ai)
#pragma unroll
            for (int m = 0; m < 4; ++m) { const int row = row0 + ai * HALF + m * 16;
                const float* bp = (row < 16384 ? base_p + (size_t)row * 1024 : base_s + (size_t)(row - 16384) * 1024) + col0; float* op = out + (size_t)row * 1024 + col0; float s = 0.f;
#pragma unroll
                for (int bj = 0; bj < 2; ++bj)
#pragma unroll
                    for (int n = 0; n < 2; ++n) { const f32x4 b = *(const f32x4*)(bp + bj * HALF + n * 16); const f32x4 o = b + acc[ai][bj][m][n] * alpha;
                        *(f32x4*)(op + bj * HALF + n * 16) = o; s += (o[0] * o[0] + o[1] * o[1]) + (o[2] * o[2] + o[3] * o[3]);
                        if (XB) { u32x2 w; w.x = cvt_pk_bf16(o[0], o[1]); w.y = cvt_pk_bf16(o[2], o[3]); *(u32x2*)(XB + (size_t)row * 1024 + col0 + bj * HALF + n * 16) = w; } }
                s += __shfl_xor(s, 16); s += __shfl_xor(s, 32);
                if (fq == 0) atomicAdd(ssq + row, s); }
    }
};
struct EpiWin {
    static constexpr bool PERM = true, AFTER_DRAIN = false;
    bf16_t* Z; const float* ssq; const float* COS; const float* SIN; float* conv_p; float* conv_s;
    __device__ __forceinline__ void operator()(const f32x4 (&acc)[2][2][4][2], const Unit& u, int wr, int wc, int fr, int fq) const {
        const int sec = u.pn >> 1; const int row0 = u.pm * BM + wr * 64 + fr;
#pragma unroll
        for (int ai = 0; ai < 2; ++ai)
#pragma unroll
            for (int m = 0; m < 4; ++m) { const int row = row0 + ai * HALF + m * 16; const float rs = rstd_of(ssq, row);
                if (sec <= 1) {
                    const int pidx = row < 16384 ? (row & 2047) : 2048 + (row & 7); const int gq = 4 * wc + fq;
                    const f32x4 c4 = *(const f32x4*)(COS + pidx * 64 + 4 * gq), s4 = *(const f32x4*)(SIN + pidx * 64 + 4 * gq); const float sc = sec == 1 ? 0.08838834764831845f * rs : rs;
#pragma unroll
                    for (int bj = 0; bj < 2; ++bj) { const int head = (u.pn & 1) * 2 + bj; const f32x4 x1 = acc[ai][bj][m][0] * sc, x2 = acc[ai][bj][m][1] * sc;
                        const f32x4 o1 = x1 * c4 - x2 * s4, o2 = x1 * s4 + x2 * c4; bf16_t* zp = Z + (size_t)row * 3072 + sec * 512 + head * 128 + 4 * gq;
                        u32x2 w1, w2; w1.x = cvt_pk_bf16(o1[0], o1[1]); w1.y = cvt_pk_bf16(o1[2], o1[3]); w2.x = cvt_pk_bf16(o2[0], o2[1]); w2.y = cvt_pk_bf16(o2[2], o2[3]);
                        *(u32x2*)zp = w1; *(u32x2*)(zp + 64) = w2; }
                } else {
#pragma unroll
                    for (int bj = 0; bj < 2; ++bj) { const int col = u.pn * BM + bj * HALF + wc * 32 + 8 * fq; f32x4 v0 = acc[ai][bj][m][0] * rs, v1 = acc[ai][bj][m][1] * rs;
                        if (sec == 3) {
#pragma unroll
                            for (int e = 0; e < 4; ++e) { v0[e] = fast_silu(v0[e]); v1[e] = fast_silu(v1[e]); } }
                        if (sec == 5) {
#pragma unroll
                            for (int e = 0; e < 4; ++e) { v0[e] = fast_gelu_tanh(v0[e]); v1[e] = fast_gelu_tanh(v1[e]); } }
                        u32x4 w; w.x = cvt_pk_bf16(v0[0], v0[1]); w.y = cvt_pk_bf16(v0[2], v0[3]); w.z = cvt_pk_bf16(v1[0], v1[1]); w.w = cvt_pk_bf16(v1[2], v1[3]);
                        *(u32x4*)(Z + (size_t)row * 3072 + col) = w;
                        if (sec == 4) {
                            float* cp = nullptr;
                            if (row < 16384) { const int t = row & 2047; if (t >= 2045) cp = conv_p + ((size_t)(row >> 11) * 3 + (t - 2045)) * 512 + (col - 2048); }
                            else { const int t = row & 7; if (t >= 5) cp = conv_s + ((size_t)((row - 16384) >> 3) * 3 + (t - 5)) * 512 + (col - 2048); }
                            if (cp) { *(f32x4*)cp = v0; *(f32x4*)(cp + 4) = v1; } } }
                } }
    }
};
struct EpiQ {
    static constexpr bool PERM = true, AFTER_DRAIN = false;
    bf16_t* Q; const float* ssq; float scale;
    __device__ __forceinline__ void operator()(const f32x4 (&acc)[2][2][4][2], const Unit& u, int wr, int wc, int fr, int fq) const {
        const int row0 = u.pm * BM + wr * 64 + fr; const int col0 = u.pn * BM + wc * 32 + 8 * fq;
#pragma unroll
        for (int ai = 0; ai < 2; ++ai)
#pragma unroll
            for (int m = 0; m < 4; ++m) { const int row = row0 + ai * HALF + m * 16; const float rs = rstd_of(ssq, row) * scale;
#pragma unroll
                for (int bj = 0; bj < 2; ++bj) { const f32x4 v0 = acc[ai][bj][m][0] * rs, v1 = acc[ai][bj][m][1] * rs;
                    u32x4 w; w.x = cvt_pk_bf16(v0[0], v0[1]); w.y = cvt_pk_bf16(v0[2], v0[3]); w.z = cvt_pk_bf16(v1[0], v1[1]); w.w = cvt_pk_bf16(v1[2], v1[3]);
                    *(u32x4*)(Q + (size_t)row * 1024 + col0 + bj * HALF) = w; } }
    }
};
struct EpiKV {
    static constexpr bool PERM = false, AFTER_DRAIN = false;
    float* outk; float* outv; bf16_t* KB; bf16_t* VB;
    __device__ __forceinline__ void operator()(const f32x4 (&acc)[2][2][4][2], const Unit& u, int wr, int wc, int fr, int fq) const {
        const int row0 = u.pm * BM + wr * 64 + fr; const bool isv = u.pn >= 4; const int col0 = (u.pn & 3) * BM + wc * 32 + 4 * fq;
        float* of = isv ? outv : outk; bf16_t* ob = isv ? VB : KB;
#pragma unroll
        for (int ai = 0; ai < 2; ++ai)
#pragma unroll
            for (int m = 0; m < 4; ++m) { const int row = row0 + ai * HALF + m * 16;
#pragma unroll
                for (int bj = 0; bj < 2; ++bj)
#pragma unroll
                    for (int n = 0; n < 2; ++n) { const f32x4 o = acc[ai][bj][m][n]; const size_t off = (size_t)row * 1024 + col0 + bj * HALF + n * 16;
                        *(f32x4*)(of + off) = o; u32x2 w; w.x = cvt_pk_bf16(o[0], o[1]); w.y = cvt_pk_bf16(o[2], o[3]); *(u32x2*)(ob + off) = w; } }
    }
};
}

#define LAS __attribute__((address_space(3)))
#define XB_TMO      128
#define XB_XCNT(j)  (256  + 64 * (j))
#define XB_XSUB(j)  (1280 + 64 * (j))
#define XB_XGEN(j)  (2304 + 64 * (j))
#define XB_TOP      3328
#define XB_TOPGEN   3392
#define XCD_BAR_WORDS 3456
#define XB_SPIN_CAP (1u << 18)

__device__ __forceinline__ unsigned xb_ld(unsigned* p)              { return __hip_atomic_load(p, __ATOMIC_RELAXED, __HIP_MEMORY_SCOPE_AGENT); }
__device__ __forceinline__ unsigned xb_add(unsigned* p, unsigned v) { return __hip_atomic_fetch_add(p, v, __ATOMIC_RELAXED, __HIP_MEMORY_SCOPE_AGENT); }
__device__ __forceinline__ unsigned xb_xcc_id() { return (unsigned)__builtin_amdgcn_s_getreg((3 << 11) | 20) & 0xFu; }
#define XB_SPIN(cond, bar) do { unsigned _sp = 0; while (cond) { __builtin_amdgcn_s_sleep(1); \
    if ((++_sp & 255u) == 0u) { if (xb_ld(&(bar)[XB_TMO])) break; if (_sp > XB_SPIN_CAP) { atomicAdd(&(bar)[XB_TMO], 1u); break; } } } } while (0)

struct XcdBarrier {
    unsigned* bar; unsigned x;
    volatile LAS unsigned* st;
};

__device__ __forceinline__ XcdBarrier xcd_barrier_post(unsigned* bar, volatile LAS unsigned* st) {
    XcdBarrier b; b.bar = bar; b.x = xb_xcc_id(); b.st = st;
    if (threadIdx.x == 0) (void)xb_add(&bar[XB_XCNT(b.x)], 1u);
    return b;
}
__device__ __forceinline__ void xcd_barrier_complete(unsigned* bar, unsigned x, unsigned& nloc, unsigned& nx) {
    const unsigned G = gridDim.x * gridDim.y * gridDim.z;
    unsigned sum, cnt, mine, sp = 0u;
    for (;;) {
        sum = 0u; cnt = 0u; mine = 0u;
#pragma unroll
        for (unsigned j = 0; j < 16; ++j) { const unsigned c = xb_ld(&bar[XB_XCNT(j)]); sum += c; cnt += (c > 0u) ? 1u : 0u; mine = (j == x) ? c : mine; }
        if (sum == G) break;
        __builtin_amdgcn_s_sleep(1);
        if ((++sp & 255u) == 0u) { if (xb_ld(&bar[XB_TMO])) break; if (sp > XB_SPIN_CAP) { atomicAdd(&bar[XB_TMO], 1u); break; } }
    }
    nloc = mine > 0u ? mine : 1u; nx = cnt > 0u ? cnt : 1u;
}

__device__ __forceinline__ void xcd_barrier(const XcdBarrier& b) {
    asm volatile("s_waitcnt vmcnt(0)" ::: "memory");
    __syncthreads();
    if (threadIdx.x == 0) {
        unsigned* bar = b.bar;
        __builtin_amdgcn_s_waitcnt(0);
        unsigned nloc = b.st[0], nx = b.st[1];
        if (nloc == 0u) { xcd_barrier_complete(bar, b.x, nloc, nx); b.st[0] = nloc; b.st[1] = nx; }
        const unsigned old = xb_add(&bar[XB_XSUB(b.x)], 1u);
        const unsigned gen = old / nloc;
        if (old + 1u == (gen + 1u) * nloc) {
            __builtin_amdgcn_fence(__ATOMIC_RELEASE, "agent");
            asm volatile("s_waitcnt vmcnt(0)" ::: "memory");
            const unsigned og = xb_add(&bar[XB_TOP], 1u);
            const unsigned tg = og / nx;
            if (og + 1u == (tg + 1u) * nx) xb_add(&bar[XB_TOPGEN], 1u);
            else XB_SPIN(xb_ld(&bar[XB_TOPGEN]) == tg, bar);
            __builtin_amdgcn_fence(__ATOMIC_ACQUIRE, "agent");
            xb_add(&bar[XB_XGEN(b.x)], 1u);
            asm volatile("s_waitcnt vmcnt(0)" ::: "memory");
        } else {
            XB_SPIN(xb_ld(&bar[XB_XGEN(b.x)]) == gen, bar);
            __builtin_amdgcn_fence(__ATOMIC_ACQUIRE, "agent");
            asm volatile("s_waitcnt vmcnt(0)" ::: "memory");
        }
    }
    __syncthreads();
}


#undef LAS

namespace mk {
using pg8::bf16_t; using pg8::bf16x8; using pg8::f32x4; using pg8::u32x4; using pg8::u32x2; using pg8::cvt_pk_bf16;
constexpr int NW = 8, NT = NW * 64;
constexpr int MP = 16384, MS = 1024, M = MP + MS, D = 1024, FF = 2816, DIN = 3072;
constexpr float QSCALE = 0.0625f * 1.4426950408889634f;
constexpr size_t O_Y = 0, O_RETP = 17825792, O_HP = O_RETP + 524288, O_CONVP = O_HP + 4096, O_MK = O_CONVP + 12288, O_MV = O_MK + 2097152, O_RETS = O_MV + 2097152, O_HS = O_RETS + 8388608, O_CONVS = O_HS + 65536;
constexpr size_t MiB = 1u << 20;
constexpr size_t WS_CTL = 0, CTL_ZERO_BYTES = 2 * MiB;
constexpr int CW_BAR = 4096;
constexpr size_t WS_SSQ = 1 * MiB;
constexpr size_t SSQ_STRIDE = 128 * 1024;
constexpr size_t WS_W = 2 * MiB;
constexpr size_t W_UP1 = WS_W, W_DN1 = W_UP1 + (size_t)2 * FF * D * 2, W_IN = W_DN1 + (size_t)D * FF * 2, W_OUT = W_IN + (size_t)DIN * D * 2, W_Q = W_OUT + (size_t)D * D * 2,
                 W_KV = W_Q + (size_t)D * D * 2, W_O = W_KV + (size_t)2 * D * D * 2, W_UP2 = W_O + (size_t)D * D * 2, W_DN2 = W_UP2 + (size_t)2 * FF * D * 2, W_END = W_DN2 + (size_t)D * FF * 2;
constexpr size_t WS_LRUW = 56 * MiB;
constexpr size_t WS_ROPE = 57 * MiB;
constexpr size_t WS_MEMB = 59 * MiB, WS_KM = 64 * MiB, WS_VM = 69 * MiB;
constexpr size_t WS_XB = 74 * MiB;
constexpr size_t WS_MIX = 110 * MiB;
constexpr size_t WS_HZ = 146 * MiB;
constexpr size_t WS_QX = WS_HZ, WS_AO = WS_HZ + 36 * MiB;
constexpr size_t WS_U = 250 * MiB;
constexpr size_t WS_SB = 282 * MiB;
constexpr size_t WS_HLOC = 298 * MiB, WS_PCUM = 332 * MiB;
constexpr size_t WS_SEG = 366 * MiB;
constexpr size_t WS_END = 368 * MiB;
static_assert(W_END <= WS_LRUW && (size_t)M * 1024 * 2 <= 36 * MiB && (size_t)M * 3072 * 2 <= 104 * MiB, "ws map");

#define GAS __attribute__((address_space(1)))
#define LAS __attribute__((address_space(3)))
typedef GAS unsigned gu32;
__device__ __forceinline__ float bf2f(unsigned short b) { return __builtin_bit_cast(float, (unsigned)b << 16); }
__device__ __forceinline__ float bflo(unsigned w) { return __builtin_bit_cast(float, w << 16); }
__device__ __forceinline__ float bfhi(unsigned w) { return __builtin_bit_cast(float, w & 0xffff0000u); }
__device__ __forceinline__ unsigned short f2bf(float f) { return (unsigned short)(cvt_pk_bf16(f, 0.f) & 0xffffu); }
__device__ __forceinline__ float wave_sum(float v) {
#pragma unroll
    for (int o = 1; o < 64; o <<= 1) v += __shfl_xor(v, o);
    return v;
}
__device__ __forceinline__ f32x4 mfma16(bf16x8 a, bf16x8 b, f32x4 c) { return __builtin_amdgcn_mfma_f32_16x16x32_bf16(a, b, c, 0, 0, 0); }
typedef short v4i16_t __attribute__((ext_vector_type(4)));
__device__ __forceinline__ bf16x8 tr_frag(LAS const unsigned char* T, int RS, int r0, int c0, int lane) {
    const int g = lane >> 4, q = (lane & 15) >> 2, p = lane & 3;
    LAS const unsigned char* a = T + (r0 + 8 * g + q) * RS + (c0 + 4 * p) * 2;
    const v4i16_t lo = __builtin_amdgcn_ds_read_tr16_b64_v4i16((LAS v4i16_t*)a);
    const v4i16_t hi = __builtin_amdgcn_ds_read_tr16_b64_v4i16((LAS v4i16_t*)(a + 4 * RS));
    return (bf16x8){lo[0], lo[1], lo[2], lo[3], hi[0], hi[1], hi[2], hi[3]};
}
__device__ __forceinline__ bf16x8 row_frag(LAS const unsigned char* T, int RS, int r0, int c0, int lane) {
    return *(LAS const bf16x8*)(T + (r0 + (lane & 15)) * RS + (c0 + 8 * (lane >> 4)) * 2);
}
struct Args { const float* in[34]; float* out; unsigned char* ws; };
}

namespace mk {
__device__ __forceinline__ int dest_row(int mode, int half, int n) {
    if (mode == 1) return 256 * (n >> 7) + 128 * half + (n & 127);
    if (mode == 2 && n < 1024) { const int f = n & 127; return (n & ~127) + 8 * ((f & 63) >> 2) + 4 * (f >> 6) + (f & 3); }
    return n;
}
__device__ __forceinline__ void transpose_item(const float* W, int K, int N, const float* gain, bf16_t* WT, int row_off, int mode, int half, LAS float* scr, int item, int lane) {
    const int nblk = N / 32, kb = item / nblk, nb = item % nblk, k0 = 64 * kb, n0 = 32 * nb;
#pragma unroll 8
    for (int i = 0; i < 32; ++i) { const int kk = 2 * i + (lane >> 5); float v = W[(size_t)(k0 + kk) * N + n0 + (lane & 31)]; if (gain) v *= gain[k0 + kk]; scr[kk * 33 + (lane & 31)] = v; }
    asm volatile("s_waitcnt lgkmcnt(0)" ::: "memory");
    const int c = lane & 7;
#pragma unroll
    for (int j = 0; j < 4; ++j) { const int n = (lane >> 3) + 8 * j; const LAS float* s = scr + (8 * c) * 33 + n;
        u32x4 o; o.x = cvt_pk_bf16(s[0 * 33], s[1 * 33]); o.y = cvt_pk_bf16(s[2 * 33], s[3 * 33]); o.z = cvt_pk_bf16(s[4 * 33], s[5 * 33]); o.w = cvt_pk_bf16(s[6 * 33], s[7 * 33]);
        *(GAS u32x4*)(WT + (size_t)(row_off + dest_row(mode, half, n0 + n)) * K + k0 + 8 * c) = o; }
    asm volatile("s_waitcnt lgkmcnt(0)" ::: "memory");
}
__device__ __forceinline__ double rope_inv_freq(int j) { return exp2(-(double)j * (13.287712379549449 / 64.0)); }

__device__ __forceinline__ void p0_prologue(const Args& a, LAS unsigned char* lds, int vcu, int G, int wave, int lane) {
    asm volatile("" : "+v"(lane));
    unsigned char* ws = a.ws;
    LAS float* scr = (LAS float*)(lds + wave * 16384);
    const int gw = vcu * NW + wave, NGW = G * NW;
    int it = gw;
#define MK_WJOB(Wp, K_, N_, gain_, dst_, roff_, mode_, half_) { const int nit = ((K_) / 64) * ((N_) / 32); \
        for (; it < nit; it += NGW) transpose_item((Wp), (K_), (N_), (gain_), (bf16_t*)(ws + (dst_)), (roff_), (mode_), (half_), scr, it, lane); it -= nit; }
    MK_WJOB(a.in[9], D, FF, a.in[8], W_UP1, 0, 1, 0) MK_WJOB(a.in[10], D, FF, a.in[8], W_UP1, 0, 1, 1) MK_WJOB(a.in[11], FF, D, nullptr, W_DN1, 0, 0, 0)
    MK_WJOB(a.in[13], D, DIN, a.in[12], W_IN, 0, 2, 0) MK_WJOB(a.in[23], D, D, nullptr, W_OUT, 0, 0, 0) MK_WJOB(a.in[25], D, D, a.in[24], W_Q, 0, 0, 0)
    MK_WJOB(a.in[26], D, D, nullptr, W_KV, 0, 0, 0) MK_WJOB(a.in[27], D, D, nullptr, W_KV, 1024, 0, 0) MK_WJOB(a.in[28], D, D, nullptr, W_O, 0, 0, 0)
    MK_WJOB(a.in[30], D, FF, a.in[29], W_UP2, 0, 1, 0) MK_WJOB(a.in[31], D, FF, a.in[29], W_UP2, 0, 1, 1) MK_WJOB(a.in[32], FF, D, nullptr, W_DN2, 0, 0, 0)
#undef MK_WJOB
    bf16_t* XB = (bf16_t*)(ws + WS_XB); float* ssq0 = (float*)(ws + WS_SSQ); bf16_t* MEMB = (bf16_t*)(ws + WS_MEMB);
    for (int r = gw; r < M + 2048; r += NGW) {
        const float* src = r < MP ? a.in[0] + (size_t)r * D : (r < M ? a.in[1] + (size_t)(r - MP) * D : a.in[7] + (size_t)(r - M) * D);
        bf16_t* dst = r < M ? XB + (size_t)r * D : MEMB + (size_t)(r - M) * D;
        const GAS f32x4* xr = (const GAS f32x4*)src + lane; f32x4 v[4]; float s = 0.f;
#pragma unroll
        for (int j = 0; j < 4; ++j) { v[j] = xr[64 * j]; s += (v[j][0] * v[j][0] + v[j][1] * v[j][1]) + (v[j][2] * v[j][2] + v[j][3] * v[j][3]); }
        s = wave_sum(s);
        GAS u32x2* o8 = (GAS u32x2*)dst + lane;
#pragma unroll
        for (int j = 0; j < 4; ++j) { u32x2 w; w.x = cvt_pk_bf16(v[j][0], v[j][1]); w.y = cvt_pk_bf16(v[j][2], v[j][3]); o8[64 * j] = w; }
        if (r < M && lane == 0) ssq0[r] = s;
    }
    const int gt = gw * 64 + lane, NGT = NGW * 64;
    float* COS = (float*)(ws + WS_ROPE); float* SIN = COS + 2056 * 64;
    for (int i = gt; i < 2056 * 64; i += NGT) { const int p = i >> 6, j = i & 63; const int pos = p < 2048 ? p : 16384 + (p - 2048);
        const double ang = (double)pos * rope_inv_freq(j); const double k = rint(ang * 0.15915494309189535); const float r = (float)(ang - k * 6.283185307179586);
        COS[i] = cosf(r); SIN[i] = sinf(r); }
    bf16_t* LW = (bf16_t*)(ws + WS_LRUW);
    for (int i = gt; i < 2 * 8 * 64 * 64; i += NGT) { const int k = i & 63, j = (i >> 6) & 63, blk = (i >> 12) & 7, which = i >> 15;
        const float* src = which ? a.in[19] : a.in[17]; LW[i] = f2bf(src[((size_t)blk * 64 + k) * 64 + j]); }
}
}

namespace mk {
constexpr int RS = 272;
constexpr int TILE = 128 * RS;
__device__ __forceinline__ float gamma_log2(int h) { return log2f(1.0f - exp2f(-5.0f - (float)h)); }

__device__ __forceinline__ void stage_tile(LAS unsigned char* T, const bf16_t* src, int ld, int tid, bool decay, float l2g) {
#pragma unroll
    for (int i = 0; i < 4; ++i) { const int q = tid + NT * i, r = q >> 4, ch = q & 15;
        u32x4 v = *(const u32x4*)(src + (size_t)r * ld + ch * 8);
        if (decay) { const float s = __builtin_amdgcn_exp2f(l2g * (float)(127 - r));
            v.x = cvt_pk_bf16(bflo(v.x) * s, bfhi(v.x) * s); v.y = cvt_pk_bf16(bflo(v.y) * s, bfhi(v.y) * s); v.z = cvt_pk_bf16(bflo(v.z) * s, bfhi(v.z) * s); v.w = cvt_pk_bf16(bflo(v.w) * s, bfhi(v.w) * s); }
        *(LAS u32x4*)(T + r * RS + ch * 16) = v; }
}
__device__ __forceinline__ void ret_u_unit(const Args& a, LAS unsigned char* lds, int unit, int tid, int wave, int lane) {
    asm volatile("" : "+v"(tid), "+v"(lane));
    const bf16_t* Z = (const bf16_t*)(a.ws + WS_HZ); float* U = (float*)(a.ws + WS_U) + (size_t)unit * 16384;
    const int c = unit & 15, h = (unit >> 4) & 3, b = unit >> 6; const int R0 = b * 2048 + c * 128; const float l2g = gamma_log2(h);
    LAS unsigned char* KT = lds; LAS unsigned char* VT = lds + TILE;
    stage_tile(KT, Z + (size_t)R0 * DIN + 512 + h * 128, DIN, tid, true, l2g);
    stage_tile(VT, Z + (size_t)R0 * DIN + 1024 + h * 128, DIN, tid, false, 0.f);
    __syncthreads();
    f32x4 acc[8];
#pragma unroll
    for (int nf = 0; nf < 8; ++nf) acc[nf] = (f32x4){0.f, 0.f, 0.f, 0.f};
#pragma unroll
    for (int ks = 0; ks < 4; ++ks) { const bf16x8 af = tr_frag(KT, RS, 32 * ks, 16 * wave, lane);
#pragma unroll
        for (int nf = 0; nf < 8; ++nf) acc[nf] = mfma16(af, tr_frag(VT, RS, 32 * ks, 16 * nf, lane), acc[nf]); }
    const int i = lane & 15, g = lane >> 4;
#pragma unroll
    for (int nf = 0; nf < 8; ++nf)
#pragma unroll
        for (int r = 0; r < 4; ++r) U[(size_t)(16 * wave + 4 * g + r) * 128 + 16 * nf + i] = acc[nf][r];
    __syncthreads();
}
__device__ __forceinline__ void ret_scan(const Args& a, int gthread) {
    const int e4 = (gthread & 31) * 4, d = (gthread >> 5) & 127, bh = gthread >> 12; if (bh >= 32) return;
    const float* U = (const float*)(a.ws + WS_U) + (size_t)bh * 16 * 16384 + d * 128 + e4; bf16_t* SB = (bf16_t*)(a.ws + WS_SB) + (size_t)bh * 16 * 16384 + d * 128 + e4;
    const float dec = exp2f(128.0f * gamma_log2(bh & 3)); f32x4 s = (f32x4){0.f, 0.f, 0.f, 0.f};
#pragma unroll 4
    for (int c = 0; c < 16; ++c) { u32x2 w; w.x = cvt_pk_bf16(s[0], s[1]); w.y = cvt_pk_bf16(s[2], s[3]); *(u32x2*)(SB + (size_t)c * 16384) = w;
        s = s * dec + *(const f32x4*)(U + (size_t)c * 16384); }
    *(f32x4*)(a.out + O_RETP + (size_t)bh * 16384 + d * 128 + e4) = s;
}
__device__ __forceinline__ void ret_out_unit(const Args& a, LAS unsigned char* lds, int unit, int tid, int wave, int lane) {
    asm volatile("" : "+v"(tid), "+v"(lane));
    const bf16_t* Z = (const bf16_t*)(a.ws + WS_HZ); const bf16_t* SB = (const bf16_t*)(a.ws + WS_SB) + (size_t)unit * 16384; bf16_t* MIX = (bf16_t*)(a.ws + WS_MIX);
    const int c = unit & 15, h = (unit >> 4) & 3, b = unit >> 6; const int R0 = b * 2048 + c * 128; const float l2g = gamma_log2(h);
    LAS unsigned char* KT = lds; LAS unsigned char* VT = lds + TILE; LAS unsigned char* ST = lds + 2 * TILE; LAS unsigned char* PW = lds + 3 * TILE + wave * (16 * RS);
    stage_tile(KT, Z + (size_t)R0 * DIN + 512 + h * 128, DIN, tid, false, 0.f);
    stage_tile(VT, Z + (size_t)R0 * DIN + 1024 + h * 128, DIN, tid, false, 0.f);
    stage_tile(ST, SB, 128, tid, false, 0.f);
    const int i = lane & 15, g = lane >> 4;
    bf16x8 qf[4];
#pragma unroll
    for (int ks = 0; ks < 4; ++ks) qf[ks] = *(const bf16x8*)(Z + (size_t)(R0 + 16 * wave + i) * DIN + h * 128 + 32 * ks + 8 * g);
    __syncthreads();
    f32x4 acc[8];
#pragma unroll
    for (int nf = 0; nf < 8; ++nf) {
        f32x4 s = (f32x4){0.f, 0.f, 0.f, 0.f};
        if (nf <= wave) {
#pragma unroll
            for (int ks = 0; ks < 4; ++ks) s = mfma16(qf[ks], row_frag(KT, RS, 16 * nf, 32 * ks, lane), s);
        }
#pragma unroll
        for (int r = 0; r < 4; ++r) { const int diff = (16 * wave + 4 * g + r) - (16 * nf + i);
            const float p = diff >= 0 ? s[r] * __builtin_amdgcn_exp2f(l2g * (float)diff) : 0.f;
            *(LAS unsigned short*)(PW + (4 * g + r) * RS + (16 * nf + i) * 2) = f2bf(p); }
    }
#pragma unroll
    for (int nf = 0; nf < 8; ++nf) acc[nf] = (f32x4){0.f, 0.f, 0.f, 0.f};
#pragma unroll
    for (int ks = 0; ks < 4; ++ks)
#pragma unroll
        for (int nf = 0; nf < 8; ++nf) acc[nf] = mfma16(qf[ks], tr_frag(ST, RS, 32 * ks, 16 * nf, lane), acc[nf]);
#pragma unroll
    for (int r = 0; r < 4; ++r) { const float sc = __builtin_amdgcn_exp2f(l2g * (float)(16 * wave + 4 * g + r + 1));
#pragma unroll
        for (int nf = 0; nf < 8; ++nf) acc[nf][r] *= sc; }
    asm volatile("s_waitcnt lgkmcnt(0)" ::: "memory");
#pragma unroll
    for (int ks = 0; ks < 4; ++ks) {
        if (2 * ks <= wave) { const bf16x8 pf = row_frag(PW, RS, 0, 32 * ks, lane);
#pragma unroll
            for (int nf = 0; nf < 8; ++nf) acc[nf] = mfma16(pf, tr_frag(VT, RS, 32 * ks, 16 * nf, lane), acc[nf]); }
    }
    const float* gain = a.in[14] + h * 128;
#pragma unroll
    for (int r = 0; r < 4; ++r) { float s = 0.f;
#pragma unroll
        for (int nf = 0; nf < 8; ++nf) s += acc[nf][r];
        s += __shfl_xor(s, 1); s += __shfl_xor(s, 2); s += __shfl_xor(s, 4); s += __shfl_xor(s, 8);
        const float mu = s * (1.0f / 128.0f); float q = 0.f;
#pragma unroll
        for (int nf = 0; nf < 8; ++nf) { const float d = acc[nf][r] - mu; q += d * d; }
        q += __shfl_xor(q, 1); q += __shfl_xor(q, 2); q += __shfl_xor(q, 4); q += __shfl_xor(q, 8);
        const float rstd = rsqrtf(q * (1.0f / 128.0f) + 1e-6f); const size_t row = (size_t)(R0 + 16 * wave + 4 * g + r);
#pragma unroll
        for (int nf = 0; nf < 8; ++nf) { const int e = 16 * nf + i; const float gt = bf2f(Z[row * DIN + 1536 + h * 128 + e]);
            MIX[row * 1024 + h * 128 + e] = f2bf((acc[nf][r] - mu) * rstd * gain[e] * gt); } }
    __syncthreads();
}
__device__ __forceinline__ void ret_sample_unit(const Args& a, LAS unsigned char* lds, int unit, int tid, int wave, int lane) {
    asm volatile("" : "+v"(tid), "+v"(lane));
    const bf16_t* Z = (const bf16_t*)(a.ws + WS_HZ); bf16_t* MIX = (bf16_t*)(a.ws + WS_MIX);
    const int h = unit & 3, b = unit >> 2; const int R0 = MP + b * 8; const float l2g = gamma_log2(h);
    LAS float* qs = (LAS float*)lds; LAS float* ks = qs + 1024; LAS float* vs = ks + 1024; LAS float* sc = vs + 1024; LAS float* red = sc + 64; LAS float* ob = red + 4 * 1024;
    for (int x = tid; x < 3072; x += NT) { const int which = x >> 10, t = (x >> 7) & 7, d = x & 127; qs[x] = bf2f(Z[(size_t)(R0 + t) * DIN + which * 512 + h * 128 + d]); }
    const int e = tid & 127, dq = tid >> 7;
    const float* S0 = a.in[2] + ((size_t)(b * 4 + h) * 128 + dq * 32) * 128 + e; float s0[32];
#pragma unroll
    for (int d = 0; d < 32; ++d) s0[d] = S0[(size_t)d * 128];
    __syncthreads();
    if (tid < 64) { const int t = tid >> 3, j = tid & 7; float s = 0.f; for (int d = 0; d < 128; ++d) s += qs[t * 128 + d] * ks[j * 128 + d]; sc[tid] = j <= t ? s * exp2f(l2g * (float)(t - j)) : 0.f; }
#pragma unroll
    for (int t = 0; t < 8; ++t) { float p = 0.f;
#pragma unroll
        for (int d = 0; d < 32; ++d) p += qs[t * 128 + dq * 32 + d] * s0[d];
        red[(dq * 8 + t) * 128 + e] = p * exp2f(l2g * (float)(t + 1)); }
    const float dec8 = exp2f(l2g * 8.0f); float* So = a.out + O_RETS + ((size_t)(b * 4 + h) * 128 + dq * 32) * 128 + e;
#pragma unroll
    for (int d = 0; d < 32; ++d) { float s = s0[d] * dec8;
#pragma unroll
        for (int j = 0; j < 8; ++j) s += exp2f(l2g * (float)(7 - j)) * ks[j * 128 + dq * 32 + d] * vs[j * 128 + e];
        So[(size_t)d * 128] = s; }
    __syncthreads();
    { const int t = tid >> 6;
        float o0 = 0.f, o1 = 0.f;
#pragma unroll
        for (int q = 0; q < 4; ++q) { o0 += red[(q * 8 + t) * 128 + lane]; o1 += red[(q * 8 + t) * 128 + lane + 64]; }
        for (int j = 0; j <= t; ++j) { const float w = sc[t * 8 + j]; o0 += w * vs[j * 128 + lane]; o1 += w * vs[j * 128 + lane + 64]; }
        const float mu = wave_sum(o0 + o1) * (1.0f / 128.0f); const float d0 = o0 - mu, d1 = o1 - mu; const float rstd = rsqrtf(wave_sum(d0 * d0 + d1 * d1) * (1.0f / 128.0f) + 1e-6f);
        const size_t row = (size_t)(R0 + t); const float* gain = a.in[14] + h * 128;
        MIX[row * 1024 + h * 128 + lane] = f2bf(d0 * rstd * gain[lane] * bf2f(Z[row * DIN + 1536 + h * 128 + lane]));
        MIX[row * 1024 + h * 128 + lane + 64] = f2bf(d1 * rstd * gain[lane + 64] * bf2f(Z[row * DIN + 1536 + h * 128 + lane + 64])); }
    __syncthreads();
}
__device__ __forceinline__ void lru_seg_unit(const Args& a, LAS unsigned char* lds, int seg, int tid, int wave, int lane) {
    asm volatile("" : "+v"(tid), "+v"(lane));
    const bf16_t* Z = (const bf16_t*)(a.ws + WS_HZ); const bf16_t* LW = (const bf16_t*)(a.ws + WS_LRUW);
    float* HLOC = (float*)(a.ws + WS_HLOC); float* PCUM = (float*)(a.ws + WS_PCUM); float* SEGP = (float*)(a.ws + WS_SEG); float* SEGH = SEGP + 128 * 512;
    const int R0 = seg * 128; const bool sample = R0 >= MP; const int i = lane & 15, g = lane >> 4; const int cb = wave * 64;
    LAS unsigned char* WF = lds + wave * 16384;
#pragma unroll
    for (int w2 = 0; w2 < 2; ++w2)
#pragma unroll
        for (int nf = 0; nf < 4; ++nf)
#pragma unroll
            for (int ks = 0; ks < 2; ++ks) *(LAS u32x4*)(WF + ((w2 * 4 + nf) * 2 + ks) * 1024 + lane * 16) = *(const u32x4*)(LW + w2 * 32768 + ((size_t)(wave * 64 + 16 * nf + i)) * 64 + 32 * ks + 8 * g);
    float ba[4], bx[4], sp8[4];
#pragma unroll
    for (int nf = 0; nf < 4; ++nf) { const int ch = cb + 16 * nf + i; ba[nf] = a.in[18][ch]; bx[nf] = a.in[20][ch]; const float l = -a.in[21][ch];
        sp8[nf] = 8.0f * ((l > 0.f ? l : 0.f) + log1pf(expf(-fabsf(l)))); }
    float prun[4], hrun[4];
#pragma unroll
    for (int nf = 0; nf < 4; ++nf) { prun[nf] = 1.0f; hrun[nf] = 0.f; }
    asm volatile("s_waitcnt lgkmcnt(0)" ::: "memory");
#pragma unroll 1
    for (int st = 0; st < 8; ++st) {
        const int row = R0 + 16 * st + i; const int t = sample ? (row & 7) : (row & 2047);
        int lo = 0; asm volatile("" : "+v"(lo));
        bf16x8 xa[2];
#pragma unroll
        for (int ks = 0; ks < 2; ++ks) { const int ch0 = cb + 32 * ks + 8 * g; float xc[8];
            { const f32x4 b0 = *(const f32x4*)(a.in[16] + lo + ch0), b1 = *(const f32x4*)(a.in[16] + lo + ch0 + 4); xc[0] = b0[0]; xc[1] = b0[1]; xc[2] = b0[2]; xc[3] = b0[3]; xc[4] = b1[0]; xc[5] = b1[1]; xc[6] = b1[2]; xc[7] = b1[3]; }
#pragma unroll
            for (int j = 0; j < 4; ++j) { const int tt = t - 3 + j; float u[8];
                const f32x4 cw0 = *(const f32x4*)(a.in[15] + lo + j * 512 + ch0), cw1 = *(const f32x4*)(a.in[15] + lo + j * 512 + ch0 + 4);
                const float cwv[8] = {cw0[0], cw0[1], cw0[2], cw0[3], cw1[0], cw1[1], cw1[2], cw1[3]};
                if (tt >= 0) { const u32x4 v = *(const u32x4*)(Z + (size_t)(row - 3 + j) * DIN + 2048 + ch0);
                    u[0] = bflo(v.x); u[1] = bfhi(v.x); u[2] = bflo(v.y); u[3] = bfhi(v.y); u[4] = bflo(v.z); u[5] = bfhi(v.z); u[6] = bflo(v.w); u[7] = bfhi(v.w); }
                else if (sample) { const float* cs = a.in[4] + ((size_t)((row - MP) >> 3) * 3 + (tt + 3)) * 512 + ch0; const f32x4 v0 = *(const f32x4*)cs, v1 = *(const f32x4*)(cs + 4);
                    u[0] = v0[0]; u[1] = v0[1]; u[2] = v0[2]; u[3] = v0[3]; u[4] = v1[0]; u[5] = v1[1]; u[6] = v1[2]; u[7] = v1[3]; }
                else {
#pragma unroll
                    for (int jj = 0; jj < 8; ++jj) u[jj] = 0.f; }
#pragma unroll
                for (int jj = 0; jj < 8; ++jj) xc[jj] += cwv[jj] * u[jj]; }
            u32x4 w; w.x = cvt_pk_bf16(xc[0], xc[1]); w.y = cvt_pk_bf16(xc[2], xc[3]); w.z = cvt_pk_bf16(xc[4], xc[5]); w.w = cvt_pk_bf16(xc[6], xc[7]);
            xa[ks] = __builtin_bit_cast(bf16x8, w); }
#pragma unroll
        for (int nf = 0; nf < 4; ++nf) {
            f32x4 ra = (f32x4){0.f, 0.f, 0.f, 0.f}, rx = (f32x4){0.f, 0.f, 0.f, 0.f}, xv = (f32x4){0.f, 0.f, 0.f, 0.f};
#pragma unroll
            for (int ks = 0; ks < 2; ++ks) {
                ra = mfma16(xa[ks], *(LAS const bf16x8*)(WF + ((0 * 4 + nf) * 2 + ks) * 1024 + lane * 16), ra);
                rx = mfma16(xa[ks], *(LAS const bf16x8*)(WF + ((1 * 4 + nf) * 2 + ks) * 1024 + lane * 16), rx);
                bf16x8 idf;
#pragma unroll
                for (int jj = 0; jj < 8; ++jj) idf[jj] = (32 * ks + 8 * g + jj == 16 * nf + i) ? (short)0x3F80 : (short)0;
                xv = mfma16(xa[ks], idf, xv); }
            float al[4], hl[4]; float p = 1.0f, hh = 0.f;
#pragma unroll
            for (int r = 0; r < 4; ++r) {
                const float rr = pg8::fast_sigmoid(ra[r] + ba[nf]), ii = pg8::fast_sigmoid(rx[r] + bx[nf]);
                const float la = -rr * sp8[nf]; const float av = __builtin_amdgcn_exp2f(la * pg8::LOG2E);
                const float y = 2.0f * la; const float em1 = (y > -0.25f) ? y * (1.0f + y * (0.5f + y * (0.16666667f + y * (0.041666668f + y * (0.0083333338f + y * 0.0013888889f))))) : __builtin_amdgcn_exp2f(y * pg8::LOG2E) - 1.0f;
                const float gx = sqrtf(-em1) * (ii * xv[r]);
                hh = av * hh + gx; p *= av; al[r] = p; hl[r] = hh; }
            const float PG = al[3], HG = hl[3];
            const float p0 = __shfl(PG, i), h0 = __shfl(HG, i), p1 = __shfl(PG, 16 + i), h1 = __shfl(HG, 16 + i), p2 = __shfl(PG, 32 + i), h2 = __shfl(HG, 32 + i);
            float pin, hin;
            if (!sample) { pin = prun[nf]; hin = hrun[nf];
                if (g > 0) { hin = h0 + p0 * hin; pin = p0 * pin; }
                if (g > 1) { hin = h1 + p1 * hin; pin = p1 * pin; }
                if (g > 2) { hin = h2 + p2 * hin; pin = p2 * pin; } }
            else { pin = (g == 1) ? p0 : ((g == 3) ? p2 : 1.0f); hin = (g == 1) ? h0 : ((g == 3) ? h2 : 0.f); }
#pragma unroll
            for (int r = 0; r < 4; ++r) { const size_t o = (size_t)(R0 + 16 * st + 4 * g + r) * 512 + cb + 16 * nf + i; HLOC[o] = hl[r] + al[r] * hin; PCUM[o] = al[r] * pin; }
            const float pe = al[3] * pin, he = hl[3] + al[3] * hin;
            prun[nf] = __shfl(pe, 48 + i); hrun[nf] = __shfl(he, 48 + i);
        }
    }
    if (!sample && g == 0) {
#pragma unroll
        for (int nf = 0; nf < 4; ++nf) { SEGP[(size_t)seg * 512 + cb + 16 * nf + i] = prun[nf]; SEGH[(size_t)seg * 512 + cb + 16 * nf + i] = hrun[nf]; } }
}
__device__ __forceinline__ void lru_scan(const Args& a, int gthread) {
    if (gthread >= 8 * 512) return; const int ch = gthread & 511, b = gthread >> 9;
    const float* SEGP = (const float*)(a.ws + WS_SEG); const float* SEGH = SEGP + 128 * 512; float* HIN = (float*)(a.ws + WS_SEG) + 2 * 128 * 512; float h = 0.f;
    for (int s = 0; s < 16; ++s) { const size_t o = (size_t)(b * 16 + s) * 512 + ch; HIN[o] = h; h = SEGH[o] + SEGP[o] * h; }
}
__device__ __forceinline__ void lru_out_row(const Args& a, int row, int lane) {
    asm volatile("" : "+v"(lane));
    const bf16_t* Z = (const bf16_t*)(a.ws + WS_HZ); bf16_t* MIX = (bf16_t*)(a.ws + WS_MIX);
    const float* HLOC = (const float*)(a.ws + WS_HLOC) + (size_t)row * 512 + 8 * lane; const float* PCUM = (const float*)(a.ws + WS_PCUM) + (size_t)row * 512 + 8 * lane;
    const bool sample = row >= MP; const int t = sample ? (row & 7) : (row & 2047); const int T = sample ? 8 : 2048;
    const float* hinp = sample ? a.in[3] + (size_t)((row - MP) >> 3) * 512 + 8 * lane : (const float*)(a.ws + WS_SEG) + 2 * 128 * 512 + (size_t)(row >> 7) * 512 + 8 * lane;
    float hs[8]; float ss = 0.f;
#pragma unroll
    for (int q = 0; q < 2; ++q) { const f32x4 hl = *(const f32x4*)(HLOC + 4 * q), pc = *(const f32x4*)(PCUM + 4 * q), hi = *(const f32x4*)(hinp + 4 * q);
#pragma unroll
        for (int e = 0; e < 4; ++e) { const float v = hl[e] + pc[e] * hi[e]; hs[4 * q + e] = v; ss += v * v; } }
    const float rstd = rsqrtf(wave_sum(ss) * (1.0f / 512.0f) + 1e-6f);
    const u32x4 gv = *(const u32x4*)(Z + (size_t)row * DIN + 2560 + 8 * lane); const float* gain = a.in[22] + 8 * lane;
    float gt[8] = {bflo(gv.x), bfhi(gv.x), bflo(gv.y), bfhi(gv.y), bflo(gv.z), bfhi(gv.z), bflo(gv.w), bfhi(gv.w)}; float o[8];
#pragma unroll
    for (int e = 0; e < 8; ++e) o[e] = hs[e] * rstd * gain[e] * gt[e];
    u32x4 w; w.x = cvt_pk_bf16(o[0], o[1]); w.y = cvt_pk_bf16(o[2], o[3]); w.z = cvt_pk_bf16(o[4], o[5]); w.w = cvt_pk_bf16(o[6], o[7]);
    *(u32x4*)(MIX + (size_t)row * 1024 + 512 + 8 * lane) = w;
    if (t == T - 1) { float* oh = sample ? a.out + O_HS + (size_t)((row - MP) >> 3) * 512 + 8 * lane : a.out + O_HP + (size_t)(row >> 11) * 512 + 8 * lane;
        *(f32x4*)oh = (f32x4){hs[0], hs[1], hs[2], hs[3]}; *(f32x4*)(oh + 4) = (f32x4){hs[4], hs[5], hs[6], hs[7]}; }
}
}

namespace mk {
constexpr int RSP = 528;
__device__ __forceinline__ void xattn_prompt_unit(const Args& a, LAS unsigned char* lds, int unit, int tid, int wave, int lane) {
    asm volatile("" : "+v"(tid), "+v"(lane));
    const bf16_t* QX = (const bf16_t*)(a.ws + WS_QX); const bf16_t* KM = (const bf16_t*)(a.ws + WS_KM); const bf16_t* VM = (const bf16_t*)(a.ws + WS_VM); bf16_t* AO = (bf16_t*)(a.ws + WS_AO);
    const int h = unit & 3, rt = unit >> 2; const int R0 = rt * 128; const int b = R0 >> 11; const int i = lane & 15, g = lane >> 4;
    LAS unsigned char* T = lds;
    LAS unsigned char* PW = lds + 256 * RS + wave * (16 * RSP);
    const bf16_t* Kb = KM + (size_t)b * 256 * 1024 + h * 256; const bf16_t* Vb = VM + (size_t)b * 256 * 1024 + h * 256;
    bf16x8 qf[8];
#pragma unroll
    for (int ks = 0; ks < 8; ++ks) qf[ks] = *(const bf16x8*)(QX + (size_t)(R0 + 16 * wave + i) * 1024 + h * 256 + 32 * ks + 8 * g);
    f32x4 s[16];
#pragma unroll
    for (int nf = 0; nf < 16; ++nf) s[nf] = (f32x4){0.f, 0.f, 0.f, 0.f};
#pragma unroll
    for (int dh = 0; dh < 2; ++dh) {
        __syncthreads();
#pragma unroll
        for (int x = 0; x < 8; ++x) { const int q = tid + NT * x, r = q >> 4, ch = q & 15; *(LAS u32x4*)(T + r * RS + ch * 16) = *(const u32x4*)(Kb + (size_t)r * 1024 + dh * 128 + ch * 8); }
        __syncthreads();
#pragma unroll
        for (int kk = 0; kk < 4; ++kk)
#pragma unroll
            for (int nf = 0; nf < 16; ++nf) s[nf] = mfma16(qf[4 * dh + kk], row_frag(T, RS, 16 * nf, 32 * kk, lane), s[nf]);
    }
    float inv[4];
#pragma unroll
    for (int r = 0; r < 4; ++r) { float m = s[0][r];
#pragma unroll
        for (int nf = 1; nf < 16; ++nf) m = fmaxf(m, s[nf][r]);
        m = fmaxf(m, __shfl_xor(m, 1)); m = fmaxf(m, __shfl_xor(m, 2)); m = fmaxf(m, __shfl_xor(m, 4)); m = fmaxf(m, __shfl_xor(m, 8));
        float l = 0.f;
#pragma unroll
        for (int nf = 0; nf < 16; ++nf) { const float p = __builtin_amdgcn_exp2f(s[nf][r] - m); l += p; *(LAS unsigned short*)(PW + (4 * g + r) * RSP + (16 * nf + i) * 2) = f2bf(p); }
        l += __shfl_xor(l, 1); l += __shfl_xor(l, 2); l += __shfl_xor(l, 4); l += __shfl_xor(l, 8);
        inv[r] = 1.0f / l; }
#pragma unroll
    for (int eh = 0; eh < 2; ++eh) {
        __syncthreads();
#pragma unroll
        for (int x = 0; x < 8; ++x) { const int q = tid + NT * x, r = q >> 4, ch = q & 15; *(LAS u32x4*)(T + r * RS + ch * 16) = *(const u32x4*)(Vb + (size_t)r * 1024 + eh * 128 + ch * 8); }
        __syncthreads();
        f32x4 o[8];
#pragma unroll
        for (int nf = 0; nf < 8; ++nf) o[nf] = (f32x4){0.f, 0.f, 0.f, 0.f};
#pragma unroll
        for (int ks = 0; ks < 8; ++ks) { const bf16x8 pf = *(LAS const bf16x8*)(PW + i * RSP + (32 * ks + 8 * g) * 2);
#pragma unroll
            for (int nf = 0; nf < 8; ++nf) o[nf] = mfma16(pf, tr_frag(T, RS, 32 * ks, 16 * nf, lane), o[nf]); }
#pragma unroll
        for (int r = 0; r < 4; ++r)
#pragma unroll
            for (int nf = 0; nf < 8; ++nf) AO[(size_t)(R0 + 16 * wave + 4 * g + r) * 1024 + h * 256 + eh * 128 + 16 * nf + i] = f2bf(o[nf][r] * inv[r]);
    }
    __syncthreads();
}
__device__ __forceinline__ void xattn_sample_unit(const Args& a, LAS unsigned char* lds, int unit, int tid, int wave, int lane) {
    asm volatile("" : "+v"(tid), "+v"(lane));
    const bf16_t* QX = (const bf16_t*)(a.ws + WS_QX); bf16_t* AO = (bf16_t*)(a.ws + WS_AO);
    const int h = unit & 3, b = unit >> 2; const int R0 = MP + b * 8;
    const float* Kc = a.in[5] + (size_t)b * 256 * 1024 + h * 256 + 4 * lane; const float* Vc = a.in[6] + (size_t)b * 256 * 1024 + h * 256 + 4 * lane;
    LAS float* SC = (LAS float*)lds;
    LAS float* RED = SC + 2048;
    float q[8][4];
#pragma unroll
    for (int t = 0; t < 8; ++t) { const u32x2 v = *(const u32x2*)(QX + (size_t)(R0 + t) * 1024 + h * 256 + 4 * lane); q[t][0] = bflo(v.x); q[t][1] = bfhi(v.x); q[t][2] = bflo(v.y); q[t][3] = bfhi(v.y); }
    __syncthreads();
#pragma unroll 4
    for (int kk = 0; kk < 32; ++kk) { const int key = 32 * wave + kk; const f32x4 kv = *(const f32x4*)(Kc + (size_t)key * 1024);
#pragma unroll
        for (int t = 0; t < 8; ++t) { float p = (q[t][0] * kv[0] + q[t][1] * kv[1]) + (q[t][2] * kv[2] + q[t][3] * kv[3]); p = wave_sum(p); if (lane == t) SC[t * 256 + key] = p; } }
    __syncthreads();
    { const int t = wave; f32x4 v = *(LAS const f32x4*)(SC + t * 256 + 4 * lane); float m = fmaxf(fmaxf(v[0], v[1]), fmaxf(v[2], v[3]));
#pragma unroll
        for (int o = 1; o < 64; o <<= 1) m = fmaxf(m, __shfl_xor(m, o));
        f32x4 p; float l = 0.f;
#pragma unroll
        for (int e = 0; e < 4; ++e) { p[e] = __builtin_amdgcn_exp2f(v[e] - m); l += p[e]; }
        l = 1.0f / wave_sum(l); *(LAS f32x4*)(SC + t * 256 + 4 * lane) = p * l; }
    __syncthreads();
    float o[8][4];
#pragma unroll
    for (int t = 0; t < 8; ++t)
#pragma unroll
        for (int e = 0; e < 4; ++e) o[t][e] = 0.f;
#pragma unroll 4
    for (int kk = 0; kk < 32; ++kk) { const int key = 32 * wave + kk; const f32x4 vv = *(const f32x4*)(Vc + (size_t)key * 1024);
#pragma unroll
        for (int t = 0; t < 8; ++t) { const float p = SC[t * 256 + key];
#pragma unroll
            for (int e = 0; e < 4; ++e) o[t][e] += p * vv[e]; } }
#pragma unroll
    for (int t = 0; t < 8; ++t) *(LAS f32x4*)(RED + (wave * 8 + t) * 256 + 4 * lane) = (f32x4){o[t][0], o[t][1], o[t][2], o[t][3]};
    __syncthreads();
    { const int t = tid >> 6, d = 4 * lane; f32x4 acc = (f32x4){0.f, 0.f, 0.f, 0.f};
#pragma unroll
        for (int w = 0; w < 8; ++w) acc += *(LAS const f32x4*)(RED + (w * 8 + t) * 256 + d);
        u32x2 wv; wv.x = cvt_pk_bf16(acc[0], acc[1]); wv.y = cvt_pk_bf16(acc[2], acc[3]); *(u32x2*)(AO + (size_t)(R0 + t) * 1024 + h * 256 + d) = wv; }
    __syncthreads();
}
}

namespace mk {
constexpr int LDS_BYTES = 163840, MISC_OFF = LDS_BYTES - 256;
#ifndef MK_PHASE_HI
#define MK_PHASE_HI 99
#endif
__global__ void __launch_bounds__(NT, 2) mega_fwd(Args a) {
    extern __shared__ __attribute__((aligned(16))) unsigned char lds_raw[];
    LAS unsigned char* lds = (LAS unsigned char*)lds_raw;
    volatile LAS unsigned* MISC = (volatile LAS unsigned*)(lds + MISC_OFF);
    const int tid = threadIdx.x, lane = tid & 63, wave = __builtin_amdgcn_readfirstlane(tid >> 6);
    const int G = gridDim.x, bx = blockIdx.x; const int vcu = (G % 8 == 0) ? (bx % 8) * (G / 8) + bx / 8 : bx;
    if (tid < 64) MISC[tid] = 0u;
    __syncthreads();
    unsigned char* ws = a.ws;
    XcdBarrier bar = xcd_barrier_post((unsigned*)((gu32*)(ws + WS_CTL) + CW_BAR), MISC + 8);
    float* Y = a.out + O_Y;
    bf16_t* XB = (bf16_t*)(ws + WS_XB); bf16_t* HB = (bf16_t*)(ws + WS_HZ); bf16_t* MIX = (bf16_t*)(ws + WS_MIX);
    float* ssq0 = (float*)(ws + WS_SSQ); float* ssq1 = (float*)(ws + WS_SSQ + SSQ_STRIDE); float* ssq2 = (float*)(ws + WS_SSQ + 2 * SSQ_STRIDE); float* ssq3 = (float*)(ws + WS_SSQ + 3 * SSQ_STRIDE); float* ssq4 = (float*)(ws + WS_SSQ + 4 * SSQ_STRIDE);
    const int gw = vcu * NW + wave, NGW = G * NW;
#define PHASE(k) if ((k) <= MK_PHASE_HI)
#define GRID_BAR() xcd_barrier(bar)
    PHASE(0) { p0_prologue(a, lds, vcu, G, wave, lane); }
    GRID_BAR();
    PHASE(1) { pg8::Gemm g{XB, (const bf16_t*)(ws + W_UP1), M, 2 * FF, D}; pg8::StaticOrder S; S.init(M, 2 * FF, G, bx); pg8::EpiSwiglu E{HB, FF, ssq0};
        pg8::gemm_phase<pg8::EpiSwiglu, pg8::StaticOrder, true, true>(lds, g, S, E); }
    GRID_BAR();
    PHASE(2) { pg8::Gemm g{HB, (const bf16_t*)(ws + W_DN1), M, D, FF}; pg8::StaticOrder S; S.init(M, D, G, bx); pg8::EpiResid E{a.in[0], a.in[1], Y, XB, ssq1, 0.5f};
        pg8::gemm_phase<pg8::EpiResid, pg8::StaticOrder, true, true>(lds, g, S, E); }
    GRID_BAR();
    PHASE(3) { pg8::Gemm g{XB, (const bf16_t*)(ws + W_IN), M, DIN, D}; pg8::StaticOrder S; S.init(M, DIN, G, bx);
        pg8::EpiWin E{HB, ssq1, (const float*)(ws + WS_ROPE), (const float*)(ws + WS_ROPE) + 2056 * 64, a.out + O_CONVP, a.out + O_CONVS};
        pg8::gemm_phase<pg8::EpiWin, pg8::StaticOrder, true, true>(lds, g, S, E); }
    GRID_BAR();
    PHASE(4) { for (int u = vcu; u < 136 + 512 + 512; u += G) { if (u < 136) { lru_seg_unit(a, lds, u, tid, wave, lane); __syncthreads(); } else if (u < 648) ret_u_unit(a, lds, u - 136, tid, wave, lane); else ret_sample_unit(a, lds, u - 648, tid, wave, lane); } }
    GRID_BAR();
    PHASE(5) { int tid5 = tid; asm volatile("" : "+v"(tid5)); for (int t = bx * NT + tid5; t < 32 * 4096; t += G * NT) ret_scan(a, t); lru_scan(a, bx * NT + tid5); }
    GRID_BAR();
    PHASE(6) { for (int u = vcu; u < 512; u += G) ret_out_unit(a, lds, u, tid, wave, lane); for (int r = gw; r < M; r += NGW) lru_out_row(a, r, lane); }
    GRID_BAR();
    PHASE(7) { { pg8::Gemm g{MIX, (const bf16_t*)(ws + W_OUT), M, D, D}; pg8::StaticOrder S; S.init(M, D, G, bx); pg8::EpiResid E{Y, Y + (size_t)MP * D, Y, XB, ssq2, 1.0f};
          pg8::gemm_phase<pg8::EpiResid, pg8::StaticOrder, true, true>(lds, g, S, E); }
        { pg8::Gemm g{(const bf16_t*)(ws + WS_MEMB), (const bf16_t*)(ws + W_KV), 2048, 2048, D}; pg8::StaticOrder S; S.init(2048, 2048, G, (bx + G - 16) % G);
          pg8::EpiKV E{a.out + O_MK, a.out + O_MV, (bf16_t*)(ws + WS_KM), (bf16_t*)(ws + WS_VM)};
          pg8::gemm_phase<pg8::EpiKV, pg8::StaticOrder, true, true>(lds, g, S, E); } }
    GRID_BAR();
    PHASE(8) { pg8::Gemm g{XB, (const bf16_t*)(ws + W_Q), M, D, D}; pg8::StaticOrder S; S.init(M, D, G, bx); pg8::EpiQ E{(bf16_t*)(ws + WS_QX), ssq2, QSCALE};
        pg8::gemm_phase<pg8::EpiQ, pg8::StaticOrder, true, true>(lds, g, S, E); }
    GRID_BAR();
    PHASE(9) { for (int u = vcu; u < 1024; u += G) { if (u < 512) xattn_prompt_unit(a, lds, u, tid, wave, lane); else xattn_sample_unit(a, lds, u - 512, tid, wave, lane); } }
    GRID_BAR();
    PHASE(10) { pg8::Gemm g{(const bf16_t*)(ws + WS_AO), (const bf16_t*)(ws + W_O), M, D, D}; pg8::StaticOrder S; S.init(M, D, G, bx); pg8::EpiResid E{Y, Y + (size_t)MP * D, Y, XB, ssq3, 1.0f};
        pg8::gemm_phase<pg8::EpiResid, pg8::StaticOrder, true, true>(lds, g, S, E); }
    GRID_BAR();
    PHASE(11) { pg8::Gemm g{XB, (const bf16_t*)(ws + W_UP2), M, 2 * FF, D}; pg8::StaticOrder S; S.init(M, 2 * FF, G, bx); pg8::EpiSwiglu E{HB, FF, ssq3};
        pg8::gemm_phase<pg8::EpiSwiglu, pg8::StaticOrder, true, true>(lds, g, S, E); }
    GRID_BAR();
    PHASE(12) { pg8::Gemm g{HB, (const bf16_t*)(ws + W_DN2), M, D, FF}; pg8::StaticOrder S; S.init(M, D, G, bx); pg8::EpiResid E{Y, Y + (size_t)MP * D, Y, nullptr, ssq4, 0.5f};
        pg8::gemm_phase<pg8::EpiResid, pg8::StaticOrder, true, true>(lds, g, S, E); }
    GRID_BAR();
    PHASE(13) { int lane13 = lane; asm volatile("" : "+v"(lane13)); for (int r = gw; r < M; r += NGW) { GAS f32x4* yr = (GAS f32x4*)(Y + (size_t)r * D) + lane13; const GAS f32x4* gn = (const GAS f32x4*)a.in[33] + lane13; const float rs = rsqrtf(ssq4[r] * (1.0f / 1024.0f) + 1e-6f);
#pragma unroll
            for (int j = 0; j < 4; ++j) yr[64 * j] = yr[64 * j] * rs * gn[64 * j]; } }
}
}

static int mk_launch(void* const* d_in, int n_in, void* d_out, void* d_ws, size_t ws_size, hipStream_t stream) {
    static int grid = 0;
    if (grid == 0) {
        int dev = 0, cus = 0, per_cu = 0;
        if (n_in != 34 || ws_size < mk::WS_END) { fprintf(stderr, "kernel_launch: n_in %d ws %zu unexpected\n", n_in, ws_size); grid = -1; return -1; }
        if (hipGetDevice(&dev) != hipSuccess || hipDeviceGetAttribute(&cus, hipDeviceAttributeMultiprocessorCount, dev) != hipSuccess) { grid = -1; return -1; }
        if (hipFuncSetAttribute((const void*)mk::mega_fwd, hipFuncAttributeMaxDynamicSharedMemorySize, mk::LDS_BYTES) != hipSuccess) { fprintf(stderr, "kernel_launch: hipFuncSetAttribute failed\n"); grid = -1; return -1; }
        if (hipOccupancyMaxActiveBlocksPerMultiprocessor(&per_cu, (const void*)mk::mega_fwd, mk::NT, mk::LDS_BYTES) != hipSuccess || per_cu < 1) { fprintf(stderr, "kernel_launch: occupancy query reports %d blocks per CU\n", per_cu); grid = -1; (void)hipGetLastError(); return -1; }
        grid = cus;
    }
    if (grid < 0) return -1;
    (void)hipMemsetAsync((char*)d_ws + mk::WS_CTL, 0, mk::CTL_ZERO_BYTES, stream);
    mk::Args a{};
    for (int i = 0; i < 34; ++i) a.in[i] = (const float*)d_in[i];
    a.out = (float*)d_out; a.ws = (unsigned char*)d_ws;
    hipLaunchKernelGGL(mk::mega_fwd, dim3(grid), dim3(mk::NT), mk::LDS_BYTES, stream, a);
    return 0;
}

extern "C" void kernel_launch(void* const* d_in, const int* in_sizes, int n_in, void* d_out, int out_size, void* d_ws, size_t ws_size, hipStream_t stream) {
    (void)in_sizes; (void)out_size; mk_launch(d_in, n_in, d_out, d_ws, ws_size, stream);
}
```

```cpp
#include <hip/hip_runtime.h>
#include <cstdio>
#include <cstdint>

namespace pg8 {
#define PG8_LAS __attribute__((address_space(3)))
typedef unsigned short bf16_t;
typedef short bf16x8 __attribute__((ext_vector_type(8)));
typedef float f32x4 __attribute__((ext_vector_type(4)));
typedef unsigned u32x4 __attribute__((ext_vector_type(4)));
constexpr int BM = 256, BK = 64, HALF = 128, HTB = HALF * BK * 2  , STAGE_BYTES = 8 * HTB, NXCD = 8, WGM = 8;

__host__ __device__ __forceinline__ int lds_byte(int r, int c) { const int st = (r >> 4) * 2 + (c >> 5), rr = r & 15, cc = c & 31, ob = rr * 64 + cc * 2; return st * 1024 + (ob ^ (((ob >> 9) & 1) << 5)); }
__host__ __device__ __forceinline__ void stage_rc(int b, int& R, int& C) { const int st = b / 1024, sb = b % 1024, swz = sb ^ (((sb >> 9) & 1) << 5); R = (st >> 1) * 16 + swz / 64; C = (st & 1) * 32 + (swz % 64) / 2; }
__host__ __device__ __forceinline__ int perm32(int rho) { const int n = rho >> 4, i = rho & 15; return 8 * (i >> 2) + 4 * n + (i & 3); }

struct Unit { int pm, pn; };
struct Gemm { const bf16_t* A; const bf16_t* Bt; int M, N, K; };

struct StaticOrder {
    int nM, nN, nwg, G, c;
    __host__ __device__ void init(int M, int N, int G_, int c_) { nM = M / BM; nN = N / BM; nwg = nM * nN; G = G_; c = c_; }
    __host__ __device__ bool next(int i, Unit& u) const {
        const long L = (long)i * G + c; if (L >= nwg) return false;
        int wgid = (int)L; { const int q = nwg / NXCD, r = nwg % NXCD, xcd = wgid % NXCD, off = wgid / NXCD; wgid = (xcd < r ? xcd * (q + 1) : r * (q + 1) + (xcd - r) * q) + off; }
        const int nig = WGM * nN, gid = wgid / nig, fm = gid * WGM, gsz = (nM - fm) < WGM ? (nM - fm) : WGM;
        u.pm = fm + ((wgid % nig) % gsz); u.pn = (wgid % nig) / gsz; return true;
    }
    __device__ __forceinline__ void a_ready(const Unit&) const {}
    __device__ __forceinline__ void done(const Unit&) const {}
};


__device__ __forceinline__ unsigned cvt_pk_bf16(float lo, float hi) { unsigned r; asm volatile("v_cvt_pk_bf16_f32 %0, %1, %2" : "=v"(r) : "v"(lo), "v"(hi)); return r; }
typedef float f32x2 __attribute__((ext_vector_type(2)));

template <class Epi, class Sched, bool ALIGN_EPI = false, bool SP2 = false>
__device__ __forceinline__ void gemm_phase(PG8_LAS unsigned char* lds, const Gemm g, const Sched& S, const Epi& E) {
    const int tid = threadIdx.x, wid = __builtin_amdgcn_readfirstlane(tid >> 6), lane = tid & 63, wr = wid >> 2, wc = wid & 3, fr = lane & 15, fq = lane >> 4;
    const int K = g.K, nt = K / BK;
    unsigned voffA[2], voffB[2];
#pragma unroll
    for (int i = 0; i < 2; ++i) { int R, C; stage_rc(tid * 16 + i * 8192, R, C); const int Rb = Epi::PERM ? ((R & ~31) + perm32(R & 31)) : R;
        voffA[i] = (unsigned)(R * K + C) * 2u; voffB[i] = (unsigned)(Rb * K + C) * 2u; }
    const size_t kstep = (size_t)(BK * 2);
    const size_t hstep = (size_t)HALF * K * 2;
    const size_t tstep = 2 * hstep;
    const unsigned ldsw = (unsigned)wid * 1024u;
    const int aoff = lds_byte(wr * 64 + fr, fq * 8), boff = lds_byte(wc * 32 + fr, fq * 8);
#define PG8_SA(b, h) (((b) * 2 + (h)) * HTB)
#define PG8_SB(b, h) ((4 + (b) * 2 + (h)) * HTB)
#define PG8_STAGE(bufoff, gbase, voff) do { _Pragma("unroll") for (int _i = 0; _i < 2; ++_i) \
        __builtin_amdgcn_global_load_lds((const unsigned*)((const char*)(gbase) + (voff)[_i]), (PG8_LAS unsigned*)(lds + (bufoff) + ldsw + _i * 8192), 16, 0, 0); } while (0)
#define PG8_LDA(dst, b, h) do { _Pragma("unroll") for (int m = 0; m < 4; ++m) _Pragma("unroll") for (int k = 0; k < 2; ++k) dst[m][k] = *(const PG8_LAS bf16x8*)(lds + PG8_SA(b, h) + aoff + m * 2048 + k * 1024); } while (0)
#define PG8_LDB(dst, b, h) do { _Pragma("unroll") for (int n = 0; n < 2; ++n) _Pragma("unroll") for (int k = 0; k < 2; ++k) dst[n][k] = *(const PG8_LAS bf16x8*)(lds + PG8_SB(b, h) + boff + n * 2048 + k * 1024); } while (0)
#define PG8_MMA(ai, bj, At, Bt) do { __builtin_amdgcn_s_setprio(1); _Pragma("unroll") for (int m = 0; m < 4; ++m) _Pragma("unroll") for (int n = 0; n < 2; ++n) _Pragma("unroll") for (int k = 0; k < 2; ++k) \
        acc[ai][bj][m][n] = __builtin_amdgcn_mfma_f32_16x16x32_bf16(Bt[n][k], At[m][k], acc[ai][bj][m][n], 0, 0, 0); __builtin_amdgcn_s_setprio(0); } while (0)
#define PG8_WAIT_V(n) asm volatile("s_waitcnt vmcnt(" #n ")" ::: "memory")
#define PG8_WAIT_L(n) asm volatile("s_waitcnt lgkmcnt(" #n ")" ::: "memory")
#define PG8_BAR __builtin_amdgcn_s_barrier()
#define PG8_SCHED __builtin_amdgcn_sched_barrier(0)
    Unit cur, nxt; int ui = 0;
    if (!S.next(0, cur)) return;
    f32x4 acc[2][2][4][2];
#pragma unroll
    for (int a = 0; a < 2; ++a)
#pragma unroll
        for (int b = 0; b < 2; ++b)
#pragma unroll
            for (int m = 0; m < 4; ++m)
#pragma unroll
                for (int n = 0; n < 2; ++n) acc[a][b][m][n] = (f32x4){0.f, 0.f, 0.f, 0.f};
    bf16x8 At[4][2], B0[2][2], B1[2][2];
    const char* cA = (const char*)g.A + (size_t)cur.pm * tstep; const char* cB = (const char*)g.Bt + (size_t)cur.pn * tstep;
    S.a_ready(cur);
    if constexpr (SP2) {
        PG8_STAGE(PG8_SB(0, 0), cB, voffB); PG8_STAGE(PG8_SB(0, 1), cB + hstep, voffB); PG8_STAGE(PG8_SA(0, 0), cA, voffA); PG8_STAGE(PG8_SA(0, 1), cA + hstep, voffA);
        if (wr == 1) PG8_BAR;
        PG8_WAIT_V(2); PG8_BAR;
        PG8_STAGE(PG8_SB(1, 0), cB + kstep, voffB); PG8_STAGE(PG8_SA(1, 0), cA + kstep, voffA); PG8_STAGE(PG8_SB(1, 1), cB + hstep + kstep, voffB);
        PG8_WAIT_V(6); PG8_BAR;
    } else {
        PG8_STAGE(PG8_SB(0, 0), cB, voffB); PG8_STAGE(PG8_SA(0, 0), cA, voffA); PG8_STAGE(PG8_SB(0, 1), cB + hstep, voffB); PG8_STAGE(PG8_SA(0, 1), cA + hstep, voffA);
        if (wr == 1) PG8_BAR;
        PG8_WAIT_V(4); PG8_BAR;
        PG8_STAGE(PG8_SB(1, 0), cB + kstep, voffB); PG8_STAGE(PG8_SA(1, 0), cA + kstep, voffA); PG8_STAGE(PG8_SB(1, 1), cB + hstep + kstep, voffB);
        PG8_WAIT_V(6); PG8_BAR;
    }
    for (;;) {
        const bool has_next = S.next(ui + 1, nxt);
        const char* nA = has_next ? (const char*)g.A + (size_t)nxt.pm * tstep : cA; const char* nB = has_next ? (const char*)g.Bt + (size_t)nxt.pn * tstep : cB;
        for (int t = 0; t < nt; t += 2) {
            const bool last = (t == nt - 2);
            const char* a1 = cA + (size_t)(t + 1) * kstep;
            const char* a2 = last ? nA : cA + (size_t)(t + 2) * kstep; const char* b2 = last ? nB : cB + (size_t)(t + 2) * kstep;
            const char* a3 = a2 + kstep; const char* b3 = b2 + kstep;
            if (last && has_next) S.a_ready(nxt);
            if constexpr (SP2) {
            PG8_LDB(B0, 0, 0); PG8_LDB(B1, 0, 1); PG8_SCHED; PG8_LDA(At, 0, 0); PG8_STAGE(PG8_SA(1, 1), a1 + hstep, voffA);
            PG8_WAIT_V(8); PG8_WAIT_L(0); PG8_BAR; PG8_MMA(0, 0, At, B0); PG8_MMA(0, 1, At, B1); PG8_BAR; PG8_SCHED;
            PG8_LDA(At, 0, 1); PG8_STAGE(PG8_SB(0, 0), b2, voffB); PG8_STAGE(PG8_SB(0, 1), b2 + hstep, voffB); PG8_STAGE(PG8_SA(0, 0), a2, voffA);
            PG8_WAIT_V(8); PG8_WAIT_L(0); PG8_BAR; PG8_MMA(1, 0, At, B0); PG8_MMA(1, 1, At, B1); PG8_BAR; PG8_SCHED;
            PG8_LDB(B0, 1, 0); PG8_LDB(B1, 1, 1); PG8_SCHED; PG8_LDA(At, 1, 0); PG8_STAGE(PG8_SA(0, 1), a2 + hstep, voffA);
            PG8_WAIT_V(8); PG8_WAIT_L(0); PG8_BAR; PG8_MMA(0, 0, At, B0); PG8_MMA(0, 1, At, B1); PG8_BAR; PG8_SCHED;
            PG8_LDA(At, 1, 1); PG8_STAGE(PG8_SB(1, 0), b3, voffB); PG8_STAGE(PG8_SB(1, 1), b3 + hstep, voffB); PG8_STAGE(PG8_SA(1, 0), a3, voffA);
            PG8_WAIT_V(8); PG8_WAIT_L(0); PG8_BAR; PG8_MMA(1, 0, At, B0); PG8_MMA(1, 1, At, B1); PG8_BAR; PG8_SCHED;
            } else {
            PG8_LDB(B0, 0, 0); PG8_SCHED; PG8_LDA(At, 0, 0); PG8_STAGE(PG8_SA(1, 1), a1 + hstep, voffA);
            PG8_WAIT_L(8); PG8_BAR; PG8_WAIT_L(0); PG8_MMA(0, 0, At, B0); PG8_BAR; PG8_SCHED;
            PG8_LDB(B1, 0, 1); PG8_STAGE(PG8_SB(0, 0), b2, voffB);
            PG8_BAR; PG8_WAIT_L(0); PG8_MMA(0, 1, At, B1); PG8_BAR;
            PG8_LDA(At, 0, 1); PG8_STAGE(PG8_SA(0, 0), a2, voffA);
            PG8_BAR; PG8_WAIT_L(0); PG8_MMA(1, 0, At, B0); PG8_BAR; PG8_SCHED;
            PG8_STAGE(PG8_SB(0, 1), b2 + hstep, voffB);
            PG8_WAIT_V(6); PG8_BAR; PG8_MMA(1, 1, At, B1); PG8_BAR;
            PG8_LDB(B0, 1, 0); PG8_SCHED; PG8_LDA(At, 1, 0); PG8_STAGE(PG8_SA(0, 1), a2 + hstep, voffA);
            PG8_WAIT_L(8); PG8_BAR; PG8_WAIT_L(0); PG8_MMA(0, 0, At, B0); PG8_BAR; PG8_SCHED;
            PG8_LDB(B1, 1, 1); PG8_STAGE(PG8_SB(1, 0), b3, voffB);
            PG8_BAR; PG8_WAIT_L(0); PG8_MMA(0, 1, At, B1); PG8_BAR;
            PG8_LDA(At, 1, 1); PG8_STAGE(PG8_SA(1, 0), a3, voffA);
            PG8_BAR; PG8_WAIT_L(0); PG8_MMA(1, 0, At, B0); PG8_BAR; PG8_SCHED;
            PG8_STAGE(PG8_SB(1, 1), b3 + hstep, voffB);
            PG8_WAIT_V(6); PG8_BAR; PG8_MMA(1, 1, At, B1); PG8_BAR;
            }
        }
        if constexpr (ALIGN_EPI) { if (wr == 0) PG8_BAR; }
        if constexpr (!Epi::AFTER_DRAIN) { E(acc, cur, wr, wc, fr, fq); S.done(cur); }
        if (!has_next) break;
#pragma unroll
        for (int a = 0; a < 2; ++a)
#pragma unroll
            for (int b = 0; b < 2; ++b)
#pragma unroll
                for (int m = 0; m < 4; ++m)
#pragma unroll
                    for (int n = 0; n < 2; ++n) acc[a][b][m][n] = (f32x4){0.f, 0.f, 0.f, 0.f};
        cur = nxt; cA = nA; cB = nB; ++ui;
        if constexpr (ALIGN_EPI) { if (wr == 1) PG8_BAR; }
    }
    PG8_WAIT_V(0);
    if constexpr (!ALIGN_EPI) { if (wr == 0) PG8_BAR; }
    PG8_BAR;
    if constexpr (Epi::AFTER_DRAIN) { E.fused(acc, cur, wr, wc, fr, fq, lds, wid, lane); S.done(cur); }
#undef PG8_SA
#undef PG8_SB
#undef PG8_STAGE
#undef PG8_LDA
#undef PG8_LDB
#undef PG8_MMA
#undef PG8_WAIT_V
#undef PG8_WAIT_L
#undef PG8_BAR
#undef PG8_SCHED
}
}

namespace pg8 {
typedef unsigned u32x2 __attribute__((ext_vector_type(2)));
constexpr float LOG2E = 1.4426950408889634f;
__device__ __forceinline__ float fast_sigmoid(float x) { return __builtin_amdgcn_rcpf(1.0f + __builtin_amdgcn_exp2f(-x * LOG2E)); }
__device__ __forceinline__ float fast_silu(float x) { return x * fast_sigmoid(x); }
__device__ __forceinline__ float fast_gelu_tanh(float x) { const float y = 0.7978845608028654f * (x + 0.044715f * x * x * x); return x * fast_sigmoid(2.0f * y); }
__device__ __forceinline__ float rstd_of(const float* ssq, int row) { return rsqrtf(ssq[row] * (1.0f / 1024.0f) + 1e-6f); }

struct EpiSwiglu {
    static constexpr bool PERM = true, AFTER_DRAIN = false;
    bf16_t* H; int ldh; const float* ssq;
    __device__ __forceinline__ void operator()(const f32x4 (&acc)[2][2][4][2], const Unit& u, int wr, int wc, int fr, int fq) const {
        const int row0 = u.pm * BM + wr * 64 + fr; const int col0 = u.pn * HALF + wc * 32 + 8 * fq;
#pragma unroll
        for (int ai = 0; ai < 2; ++ai)
#pragma unroll
            for (int m = 0; m < 4; ++m) { const int row = row0 + ai * HALF + m * 16; const float rs = rstd_of(ssq, row);
                float h[8];
#pragma unroll
                for (int n = 0; n < 2; ++n)
#pragma unroll
                    for (int e = 0; e < 4; ++e) { const float g = acc[ai][0][m][n][e] * rs, uu = acc[ai][1][m][n][e] * rs; h[4 * n + e] = fast_silu(g) * uu; }
                u32x4 w; w.x = cvt_pk_bf16(h[0], h[1]); w.y = cvt_pk_bf16(h[2], h[3]); w.z = cvt_pk_bf16(h[4], h[5]); w.w = cvt_pk_bf16(h[6], h[7]);
                *(u32x4*)(H + (size_t)row * ldh + col0) = w; }
    }
};
struct EpiResid {
    static constexpr bool PERM = false, AFTER_DRAIN = false;
    const float* base_p; const float* base_s; float* out; bf16_t* XB; float* ssq; float alpha;
    __device__ __forceinline__ void operator()(const f32x4 (&acc)[2][2][4][2], const Unit& u, int wr, int wc, int fr, int fq) const {
        const int row0 = u.pm * BM + wr * 64 + fr, col0 = u.pn * BM + wc * 32 + 4 * fq;
#pragma unroll
        for (int ai = 0; ai < 2; ++ai)
#pragma unroll
            for (int m = 0; m < 4; ++m) { const int row = row0 + ai * HALF + m * 16;
                const float* bp = (row < 16384 ? base_p + (size_t)row * 1024 : base_s + (size_t)(row - 16384) * 1024) + col0; float* op = out + (size_t)row * 1024 + col0; float s = 0.f;
#pragma unroll
                for (int bj = 0; bj < 2; ++bj)
#pragma unroll
                    for (int n = 0; n < 2; ++n) { const f32x4 b = *(const f32x4*)(bp + bj * HALF + n * 16); const f32x4 o = b + acc[ai][bj][m][n] * alpha;
                        *(f32x4*)(op + bj * HALF + n * 16) = o; s += (o[0] * o[0] + o[1] * o[1]) + (o[2] * o[2] + o[3] * o[3]);
                        if (XB) { u32x2 w; w.x = cvt_pk_bf16(o[0], o[1]); w.y = cvt_pk_bf16(o[2], o[3]); *(u32x2*)(XB + (size_t)row * 1024 + col0 + bj * HALF + n * 16) = w; } }
                s += __shfl_xor(s, 16); s += __shfl_xor(s, 32);
                if (fq == 0) atomicAdd(ssq + row, s); }
    }
};
struct EpiWin {
    static constexpr bool PERM = true, AFTER_DRAIN = false;
    bf16_t* Z; const float* ssq; const float* COS; const float* SIN; float* conv_p; float* conv_s;
    __device__ __forceinline__ void operator()(const f32x4 (&acc)[2][2][4][2], const Unit& u, int wr, int wc, int fr, int fq) const {
        const int sec = u.pn >> 1; const int row0 = u.pm * BM + wr * 64 + fr;
#pragma unroll
        for (int ai = 0; ai < 2; ++ai)
#pragma unroll
            for (int m = 0; m < 4; ++m) { const int row = row0 + ai * HALF + m * 16; const float rs = rstd_of(ssq, row);
                if (sec <= 1) {
                    const int pidx = row < 16384 ? (row & 2047) : 2048 + (row & 7); const int gq = 4 * wc + fq;
                    const f32x4 c4 = *(const f32x4*)(COS + pidx * 64 + 4 * gq), s4 = *(const f32x4*)(SIN + pidx * 64 + 4 * gq); const float sc = sec == 1 ? 0.08838834764831845f * rs : rs;
#pragma unroll
                    for (int bj = 0; bj < 2; ++bj) { const int head = (u.pn & 1) * 2 + bj; const f32x4 x1 = acc[ai][bj][m][0] * sc, x2 = acc[ai][bj][m][1] * sc;
                        const f32x4 o1 = x1 * c4 - x2 * s4, o2 = x1 * s4 + x2 * c4; bf16_t* zp = Z + (size_t)row * 3072 + sec * 512 + head * 128 + 4 * gq;
                        u32x2 w1, w2; w1.x = cvt_pk_bf16(o1[0], o1[1]); w1.y = cvt_pk_bf16(o1[2], o1[3]); w2.x = cvt_pk_bf16(o2[0], o2[1]); w2.y = cvt_pk_bf16(o2[2], o2[3]);
                        *(u32x2*)zp = w1; *(u32x2*)(zp + 64) = w2; }
                } else {
#pragma unroll
                    for (int bj = 0; bj < 2; ++bj) { const int col = u.pn * BM + bj * HALF + wc * 32 + 8 * fq; f32x4 v0 = acc[ai][bj][m][0] * rs, v1 = acc[ai][bj][m][1] * rs;
                        if (sec == 3) {
#pragma unroll
                            for (int e = 0; e < 4; ++e) { v0[e] = fast_silu(v0[e]); v1[e] = fast_silu(v1[e]); } }
                        if (sec == 5) {
#pragma unroll
                            for (int e = 0; e < 4; ++e) { v0[e] = fast_gelu_tanh(v0[e]); v1[e] = fast_gelu_tanh(v1[e]); } }
                        u32x4 w; w.x = cvt_pk_bf16(v0[0], v0[1]); w.y = cvt_pk_bf16(v0[2], v0[3]); w.z = cvt_pk_bf16(v1[0], v1[1]); w.w = cvt_pk_bf16(v1[2], v1[3]);
                        *(u32x4*)(Z + (size_t)row * 3072 + col) = w;
                        if (sec == 4) {
                            float* cp = nullptr;
                            if (row < 16384) { const int t = row & 2047; if (t >= 2045) cp = conv_p + ((size_t)(row >> 11) * 3 + (t - 2045)) * 512 + (col - 2048); }
                            else { const int t = row & 7; if (t >= 5) cp = conv_s + ((size_t)((row - 16384) >> 3) * 3 + (t - 5)) * 512 + (col - 2048); }
                            if (cp) { *(f32x4*)cp = v0; *(f32x4*)(cp + 4) = v1; } } }
                } }
    }
};
struct EpiQ {
    static constexpr bool PERM = true, AFTER_DRAIN = false;
    bf16_t* Q; const float* ssq; float scale;
    __device__ __forceinline__ void operator()(const f32x4 (&acc)[2][2][4][2], const Unit& u, int wr, int wc, int fr, int fq) const {
        const int row0 = u.pm * BM + wr * 64 + fr; const int col0 = u.pn * BM + wc * 32 + 8 * fq;
#pragma unroll
        for (int ai = 0; ai < 2; ++ai)
#pragma unroll
            for (int m = 0; m < 4; ++m) { const int row = row0 + ai * HALF + m * 16; const float rs = rstd_of(ssq, row) * scale;
#pragma unroll
                for (int bj = 0; bj < 2; ++bj) { const f32x4 v0 = acc[ai][bj][m][0] * rs, v1 = acc[ai][bj][m][1] * rs;
                    u32x4 w; w.x = cvt_pk_bf16(v0[0], v0[1]); w.y = cvt_pk_bf16(v0[2], v0[3]); w.z = cvt_pk_bf16(v1[0], v1[1]); w.w = cvt_pk_bf16(v1[2], v1[3]);
                    *(u32x4*)(Q + (size_t)row * 1024 + col0 + bj * HALF) = w; } }
    }
};
struct EpiKV {
    static constexpr bool PERM = false, AFTER_DRAIN = false;
    float* outk; float* outv; bf16_t* KB; bf16_t* VB;
    __device__ __forceinline__ void operator()(const f32x4 (&acc)[2][2][4][2], const Unit& u, int wr, int wc, int fr, int fq) const {
        const int row0 = u.pm * BM + wr * 64 + fr; const bool isv = u.pn >= 4; const int col0 = (u.pn & 3) * BM + wc * 32 + 4 * fq;
        float* of = isv ? outv : outk; bf16_t* ob = isv ? VB : KB;
#pragma unroll
        for (int ai = 0; ai < 2; ++ai)
#pragma unroll
            for (int m = 0; m < 4; ++m) { const int row = row0 + ai * HALF + m * 16;
#pragma unroll
                for (int bj = 0; bj < 2; ++bj)
#pragma unroll
                    for (int n = 0; n < 2; ++n) { const f32x4 o = acc[ai][bj][m][n]; const size_t off = (size_t)row * 1024 + col0 + bj * HALF + n * 16;
                        *(f32x4*)(of + off) = o; u32x2 w; w.x = cvt_pk_bf16(o[0], o[1]); w.y = cvt_pk_bf16(o[2], o[3]); *(u32x2*)(ob + off) = w; } }
    }
};
}

#define LAS __attribute__((address_space(3)))
#define XB_TMO      128
#define XB_XCNT(j)  (256  + 64 * (j))
#define XB_XSUB(j)  (1280 + 64 * (j))
#define XB_XGEN(j)  (2304 + 64 * (j))
#define XB_TOP      3328
#define XB_TOPGEN   3392
#define XCD_BAR_WORDS 3456
#define XB_SPIN_CAP (1u << 18)

__device__ __forceinline__ unsigned xb_ld(unsigned* p)              { return __hip_atomic_load(p, __ATOMIC_RELAXED, __HIP_MEMORY_SCOPE_AGENT); }
__device__ __forceinline__ unsigned xb_add(unsigned* p, unsigned v) { return __hip_atomic_fetch_add(p, v, __ATOMIC_RELAXED, __HIP_MEMORY_SCOPE_AGENT); }
__device__ __forceinline__ unsigned xb_xcc_id() { return (unsigned)__builtin_amdgcn_s_getreg((3 << 11) | 20) & 0xFu; }
#define XB_SPIN(cond, bar) do { unsigned _sp = 0; while (cond) { __builtin_amdgcn_s_sleep(1); \
    if ((++_sp & 255u) == 0u) { if (xb_ld(&(bar)[XB_TMO])) break; if (_sp > XB_SPIN_CAP) { atomicAdd(&(bar)[XB_TMO], 1u); break; } } } } while (0)

struct XcdBarrier {
    unsigned* bar; unsigned x;
    volatile LAS unsigned* st;
};

__device__ __forceinline__ XcdBarrier xcd_barrier_post(unsigned* bar, volatile LAS unsigned* st) {
    XcdBarrier b; b.bar = bar; b.x = xb_xcc_id(); b.st = st;
    if (threadIdx.x == 0) (void)xb_add(&bar[XB_XCNT(b.x)], 1u);
    return b;
}
__device__ __forceinline__ void xcd_barrier_complete(unsigned* bar, unsigned x, unsigned& nloc, unsigned& nx) {
    const unsigned G = gridDim.x * gridDim.y * gridDim.z;
    unsigned sum, cnt, mine, sp = 0u;
    for (;;) {
        sum = 0u; cnt = 0u; mine = 0u;
#pragma unroll
        for (unsigned j = 0; j < 16; ++j) { const unsigned c = xb_ld(&bar[XB_XCNT(j)]); sum += c; cnt += (c > 0u) ? 1u : 0u; mine = (j == x) ? c : mine; }
        if (sum == G) break;
        __builtin_amdgcn_s_sleep(1);
        if ((++sp & 255u) == 0u) { if (xb_ld(&bar[XB_TMO])) break; if (sp > XB_SPIN_CAP) { atomicAdd(&bar[XB_TMO], 1u); break; } }
    }
    nloc = mine > 0u ? mine : 1u; nx = cnt > 0u ? cnt : 1u;
}

__device__ __forceinline__ void xcd_barrier(const XcdBarrier& b) {
    asm volatile("s_waitcnt vmcnt(0)" ::: "memory");
    __syncthreads();
    if (threadIdx.x == 0) {
        unsigned* bar = b.bar;
        __builtin_amdgcn_s_waitcnt(0);
        unsigned nloc = b.st[0], nx = b.st[1];
        if (nloc == 0u) { xcd_barrier_complete(bar, b.x, nloc, nx); b.st[0] = nloc; b.st[1] = nx; }
        const unsigned old = xb_add(&bar[XB_XSUB(b.x)], 1u);
        const unsigned gen = old / nloc;
        if (old + 1u == (gen + 1u) * nloc) {
            __builtin_amdgcn_fence(__ATOMIC_RELEASE, "agent");
            asm volatile("s_waitcnt vmcnt(0)" ::: "memory");
            const unsigned og = xb_add(&bar[XB_TOP], 1u);
            const unsigned tg = og / nx;
            if (og + 1u == (tg + 1u) * nx) xb_add(&bar[XB_TOPGEN], 1u);
            else XB_SPIN(xb_ld(&bar[XB_TOPGEN]) == tg, bar);
            __builtin_amdgcn_fence(__ATOMIC_ACQUIRE, "agent");
            xb_add(&bar[XB_XGEN(b.x)], 1u);
            asm volatile("s_waitcnt vmcnt(0)" ::: "memory");
        } else {
            XB_SPIN(xb_ld(&bar[XB_XGEN(b.x)]) == gen, bar);
            __builtin_amdgcn_fence(__ATOMIC_ACQUIRE, "agent");
            asm volatile("s_waitcnt vmcnt(0)" ::: "memory");
        }
    }
    __syncthreads();
}


#undef LAS

namespace mk {
using pg8::bf16_t; using pg8::bf16x8; using pg8::f32x4; using pg8::u32x4; using pg8::u32x2; using pg8::cvt_pk_bf16;
constexpr int NW = 8, NT = NW * 64;
constexpr int MP = 16384, MS = 1024, M = MP + MS, D = 1024, FF = 2816, DIN = 3072;
constexpr float QSCALE = 0.0625f * 1.4426950408889634f;
constexpr size_t O_Y = 0, O_RETP = 17825792, O_HP = O_RETP + 524288, O_CONVP = O_HP + 4096, O_MK = O_CONVP + 12288, O_MV = O_MK + 2097152, O_RETS = O_MV + 2097152, O_HS = O_RETS + 8388608, O_CONVS = O_HS + 65536;
constexpr size_t MiB = 1u << 20;
constexpr size_t WS_CTL = 0, CTL_ZERO_BYTES = 2 * MiB;
constexpr int CW_BAR = 4096, CW_QUEUE = 16384;
constexpr size_t WS_SSQ = 1 * MiB;
constexpr size_t SSQ_STRIDE = 128 * 1024;
constexpr size_t WS_W = 2 * MiB;
constexpr size_t W_UP1 = WS_W, W_DN1 = W_UP1 + (size_t)2 * FF * D * 2, W_IN = W_DN1 + (size_t)D * FF * 2, W_OUT = W_IN + (size_t)DIN * D * 2, W_Q = W_OUT + (size_t)D * D * 2,
                 W_KV = W_Q + (size_t)D * D * 2, W_O = W_KV + (size_t)2 * D * D * 2, W_UP2 = W_O + (size_t)D * D * 2, W_DN2 = W_UP2 + (size_t)2 * FF * D * 2, W_END = W_DN2 + (size_t)D * FF * 2;
constexpr size_t WS_LRUW = 56 * MiB;
constexpr size_t WS_ROPE = 57 * MiB;
constexpr size_t WS_MEMB = 59 * MiB, WS_KM = 64 * MiB, WS_VM = 69 * MiB;
constexpr size_t WS_XB = 74 * MiB;
constexpr size_t WS_MIX = 110 * MiB;
constexpr size_t WS_HZ = 146 * MiB;
constexpr size_t WS_QX = WS_HZ, WS_AO = WS_HZ + 36 * MiB;
constexpr size_t WS_U = 250 * MiB;
constexpr size_t WS_SB = 282 * MiB;
constexpr size_t WS_HLOC = 298 * MiB, WS_PCUM = 332 * MiB;
constexpr size_t WS_SEG = 366 * MiB;
constexpr size_t WS_END = 368 * MiB;
static_assert(W_END <= WS_LRUW && (size_t)M * 1024 * 2 <= 36 * MiB && (size_t)M * 3072 * 2 <= 104 * MiB, "ws map");

#define GAS __attribute__((address_space(1)))
#define LAS __attribute__((address_space(3)))
typedef GAS unsigned gu32;
__device__ __forceinline__ float bf2f(unsigned short b) { return __builtin_bit_cast(float, (unsigned)b << 16); }
__device__ __forceinline__ float bflo(unsigned w) { return __builtin_bit_cast(float, w << 16); }
__device__ __forceinline__ float bfhi(unsigned w) { return __builtin_bit_cast(float, w & 0xffff0000u); }
__device__ __forceinline__ unsigned short f2bf(float f) { return (unsigned short)(cvt_pk_bf16(f, 0.f) & 0xffffu); }
__device__ __forceinline__ float wave_sum(float v) {
#pragma unroll
    for (int o = 1; o < 64; o <<= 1) v += __shfl_xor(v, o);
    return v;
}
__device__ __forceinline__ f32x4 mfma16(bf16x8 a, bf16x8 b, f32x4 c) { return __builtin_amdgcn_mfma_f32_16x16x32_bf16(a, b, c, 0, 0, 0); }
typedef short v4i16_t __attribute__((ext_vector_type(4)));
__device__ __forceinline__ bf16x8 tr_frag(LAS const unsigned char* T, int RS, int r0, int c0, int lane) {
    const int g = lane >> 4, q = (lane & 15) >> 2, p = lane & 3;
    LAS const unsigned char* a = T + (r0 + 8 * g + q) * RS + (c0 + 4 * p) * 2;
    const v4i16_t lo = __builtin_amdgcn_ds_read_tr16_b64_v4i16((LAS v4i16_t*)a);
    const v4i16_t hi = __builtin_amdgcn_ds_read_tr16_b64_v4i16((LAS v4i16_t*)(a + 4 * RS));
    return (bf16x8){lo[0], lo[1], lo[2], lo[3], hi[0], hi[1], hi[2], hi[3]};
}
__device__ __forceinline__ bf16x8 row_frag(LAS const unsigned char* T, int RS, int r0, int c0, int lane) {
    return *(LAS const bf16x8*)(T + (r0 + (lane & 15)) * RS + (c0 + 8 * (lane >> 4)) * 2);
}
struct Args { const float* in[34]; float* out; unsigned char* ws; };
}

namespace mk {
__device__ __forceinline__ int dest_row(int mode, int half, int n) {
    if (mode == 1) return 256 * (n >> 7) + 128 * half + (n & 127);
    if (mode == 2 && n < 1024) { const int f = n & 127; return (n & ~127) + 8 * ((f & 63) >> 2) + 4 * (f >> 6) + (f & 3); }
    return n;
}
__device__ __forceinline__ void transpose_item(const float* W, int K, int N, const float* gain, bf16_t* WT, int row_off, int mode, int half, LAS float* scr, int item, int lane) {
    const int nblk = N / 32, kb = item / nblk, nb = item % nblk, k0 = 64 * kb, n0 = 32 * nb;
#pragma unroll 8
    for (int i = 0; i < 32; ++i) { const int kk = 2 * i + (lane >> 5); float v = W[(size_t)(k0 + kk) * N + n0 + (lane & 31)]; if (gain) v *= gain[k0 + kk]; scr[kk * 33 + (lane & 31)] = v; }
    asm volatile("s_waitcnt lgkmcnt(0)" ::: "memory");
    const int c = lane & 7;
#pragma unroll
    for (int j = 0; j < 4; ++j) { const int n = (lane >> 3) + 8 * j; const LAS float* s = scr + (8 * c) * 33 + n;
        u32x4 o; o.x = cvt_pk_bf16(s[0 * 33], s[1 * 33]); o.y = cvt_pk_bf16(s[2 * 33], s[3 * 33]); o.z = cvt_pk_bf16(s[4 * 33], s[5 * 33]); o.w = cvt_pk_bf16(s[6 * 33], s[7 * 33]);
        *(GAS u32x4*)(WT + (size_t)(row_off + dest_row(mode, half, n0 + n)) * K + k0 + 8 * c) = o; }
    asm volatile("s_waitcnt lgkmcnt(0)" ::: "memory");
}
__device__ __forceinline__ double rope_inv_freq(int j) { return exp2(-(double)j * (13.287712379549449 / 64.0)); }

__device__ __forceinline__ void p0_prologue(const Args& a, LAS unsigned char* lds, int vcu, int G, int wave, int lane) {
    asm volatile("" : "+v"(lane));
    unsigned char* ws = a.ws;
    LAS float* scr = (LAS float*)(lds + wave * 16384);
    const int gw = vcu * NW + wave, NGW = G * NW;
    int it = gw;
#define MK_WJOB(Wp, K_, N_, gain_, dst_, roff_, mode_, half_) { const int nit = ((K_) / 64) * ((N_) / 32); \
        for (; it < nit; it += NGW) transpose_item((Wp), (K_), (N_), (gain_), (bf16_t*)(ws + (dst_)), (roff_), (mode_), (half_), scr, it, lane); it -= nit; }
    MK_WJOB(a.in[9], D, FF, a.in[8], W_UP1, 0, 1, 0) MK_WJOB(a.in[10], D, FF, a.in[8], W_UP1, 0, 1, 1) MK_WJOB(a.in[11], FF, D, nullptr, W_DN1, 0, 0, 0)
    MK_WJOB(a.in[13], D, DIN, a.in[12], W_IN, 0, 2, 0) MK_WJOB(a.in[23], D, D, nullptr, W_OUT, 0, 0, 0) MK_WJOB(a.in[25], D, D, a.in[24], W_Q, 0, 0, 0)
    MK_WJOB(a.in[26], D, D, nullptr, W_KV, 0, 0, 0) MK_WJOB(a.in[27], D, D, nullptr, W_KV, 1024, 0, 0) MK_WJOB(a.in[28], D, D, nullptr, W_O, 0, 0, 0)
    MK_WJOB(a.in[30], D, FF, a.in[29], W_UP2, 0, 1, 0) MK_WJOB(a.in[31], D, FF, a.in[29], W_UP2, 0, 1, 1) MK_WJOB(a.in[32], FF, D, nullptr, W_DN2, 0, 0, 0)
#undef MK_WJOB
    bf16_t* XB = (bf16_t*)(ws + WS_XB); float* ssq0 = (float*)(ws + WS_SSQ); bf16_t* MEMB = (bf16_t*)(ws + WS_MEMB);
    for (int r = gw; r < M + 2048; r += NGW) {
        const float* src = r < MP ? a.in[0] + (size_t)r * D : (r < M ? a.in[1] + (size_t)(r - MP) * D : a.in[7] + (size_t)(r - M) * D);
        bf16_t* dst = r < M ? XB + (size_t)r * D : MEMB + (size_t)(r - M) * D;
        const GAS f32x4* xr = (const GAS f32x4*)src + lane; f32x4 v[4]; float s = 0.f;
#pragma unroll
        for (int j = 0; j < 4; ++j) { v[j] = xr[64 * j]; s += (v[j][0] * v[j][0] + v[j][1] * v[j][1]) + (v[j][2] * v[j][2] + v[j][3] * v[j][3]); }
        s = wave_sum(s);
        GAS u32x2* o8 = (GAS u32x2*)dst + lane;
#pragma unroll
        for (int j = 0; j < 4; ++j) { u32x2 w; w.x = cvt_pk_bf16(v[j][0], v[j][1]); w.y = cvt_pk_bf16(v[j][2], v[j][3]); o8[64 * j] = w; }
        if (r < M && lane == 0) ssq0[r] = s;
    }
    const int gt = gw * 64 + lane, NGT = NGW * 64;
    float* COS = (float*)(ws + WS_ROPE); float* SIN = COS + 2056 * 64;
    for (int i = gt; i < 2056 * 64; i += NGT) { const int p = i >> 6, j = i & 63; const int pos = p < 2048 ? p : 16384 + (p - 2048);
        const double ang = (double)pos * rope_inv_freq(j); const double k = rint(ang * 0.15915494309189535); const float r = (float)(ang - k * 6.283185307179586);
        COS[i] = cosf(r); SIN[i] = sinf(r); }
    bf16_t* LW = (bf16_t*)(ws + WS_LRUW);
    for (int i = gt; i < 2 * 8 * 64 * 64; i += NGT) { const int k = i & 63, j = (i >> 6) & 63, blk = (i >> 12) & 7, which = i >> 15;
        const float* src = which ? a.in[19] : a.in[17]; LW[i] = f2bf(src[((size_t)blk * 64 + k) * 64 + j]); }
}
}

namespace mk {
constexpr int RS = 272;
constexpr int TILE = 128 * RS;
__device__ __forceinline__ float gamma_log2(int h) { return log2f(1.0f - exp2f(-5.0f - (float)h)); }

__device__ __forceinline__ void stage_tile(LAS unsigned char* T, const bf16_t* src, int ld, int tid, bool decay, float l2g) {
#pragma unroll
    for (int i = 0; i < 4; ++i) { const int q = tid + NT * i, r = q >> 4, ch = q & 15;
        u32x4 v = *(const u32x4*)(src + (size_t)r * ld + ch * 8);
        if (decay) { const float s = __builtin_amdgcn_exp2f(l2g * (float)(127 - r));
            v.x = cvt_pk_bf16(bflo(v.x) * s, bfhi(v.x) * s); v.y = cvt_pk_bf16(bflo(v.y) * s, bfhi(v.y) * s); v.z = cvt_pk_bf16(bflo(v.z) * s, bfhi(v.z) * s); v.w = cvt_pk_bf16(bflo(v.w) * s, bfhi(v.w) * s); }
        *(LAS u32x4*)(T + r * RS + ch * 16) = v; }
}
__device__ __forceinline__ void ret_u_unit(const Args& a, LAS unsigned char* lds, int unit, int tid, int wave, int lane) {
    asm volatile("" : "+v"(tid), "+v"(lane));
    const bf16_t* Z = (const bf16_t*)(a.ws + WS_HZ); float* U = (float*)(a.ws + WS_U) + (size_t)unit * 16384;
    const int c = unit & 15, h = (unit >> 4) & 3, b = unit >> 6; const int R0 = b * 2048 + c * 128; const float l2g = gamma_log2(h);
    LAS unsigned char* KT = lds; LAS unsigned char* VT = lds + TILE;
    stage_tile(KT, Z + (size_t)R0 * DIN + 512 + h * 128, DIN, tid, true, l2g);
    stage_tile(VT, Z + (size_t)R0 * DIN + 1024 + h * 128, DIN, tid, false, 0.f);
    __syncthreads();
    f32x4 acc[8];
#pragma unroll
    for (int nf = 0; nf < 8; ++nf) acc[nf] = (f32x4){0.f, 0.f, 0.f, 0.f};
#pragma unroll
    for (int ks = 0; ks < 4; ++ks) { const bf16x8 af = tr_frag(KT, RS, 32 * ks, 16 * wave, lane);
#pragma unroll
        for (int nf = 0; nf < 8; ++nf) acc[nf] = mfma16(af, tr_frag(VT, RS, 32 * ks, 16 * nf, lane), acc[nf]); }
    const int i = lane & 15, g = lane >> 4;
#pragma unroll
    for (int nf = 0; nf < 8; ++nf)
#pragma unroll
        for (int r = 0; r < 4; ++r) U[(size_t)(16 * wave + 4 * g + r) * 128 + 16 * nf + i] = acc[nf][r];
    __syncthreads();
}
__device__ __forceinline__ void ret_scan(const Args& a, int gthread) {
    const int e4 = (gthread & 31) * 4, d = (gthread >> 5) & 127, bh = gthread >> 12; if (bh >= 32) return;
    const float* U = (const float*)(a.ws + WS_U) + (size_t)bh * 16 * 16384 + d * 128 + e4; bf16_t* SB = (bf16_t*)(a.ws + WS_SB) + (size_t)bh * 16 * 16384 + d * 128 + e4;
    const float dec = exp2f(128.0f * gamma_log2(bh & 3)); f32x4 s = (f32x4){0.f, 0.f, 0.f, 0.f};
#pragma unroll 4
    for (int c = 0; c < 16; ++c) { u32x2 w; w.x = cvt_pk_bf16(s[0], s[1]); w.y = cvt_pk_bf16(s[2], s[3]); *(u32x2*)(SB + (size_t)c * 16384) = w;
        s = s * dec + *(const f32x4*)(U + (size_t)c * 16384); }
    *(f32x4*)(a.out + O_RETP + (size_t)bh * 16384 + d * 128 + e4) = s;
}
__device__ __forceinline__ void ret_out_unit(const Args& a, LAS unsigned char* lds, int unit, int tid, int wave, int lane) {
    asm volatile("" : "+v"(tid), "+v"(lane));
    const bf16_t* Z = (const bf16_t*)(a.ws + WS_HZ); const bf16_t* SB = (const bf16_t*)(a.ws + WS_SB) + (size_t)unit * 16384; bf16_t* MIX = (bf16_t*)(a.ws + WS_MIX);
    const int c = unit & 15, h = (unit >> 4) & 3, b = unit >> 6; const int R0 = b * 2048 + c * 128; const float l2g = gamma_log2(h);
    LAS unsigned char* KT = lds; LAS unsigned char* VT = lds + TILE; LAS unsigned char* ST = lds + 2 * TILE; LAS unsigned char* PW = lds + 3 * TILE + wave * (16 * RS);
    stage_tile(KT, Z + (size_t)R0 * DIN + 512 + h * 128, DIN, tid, false, 0.f);
    stage_tile(VT, Z + (size_t)R0 * DIN + 1024 + h * 128, DIN, tid, false, 0.f);
    stage_tile(ST, SB, 128, tid, false, 0.f);
    const int i = lane & 15, g = lane >> 4;
    bf16x8 qf[4];
#pragma unroll
    for (int ks = 0; ks < 4; ++ks) qf[ks] = *(const bf16x8*)(Z + (size_t)(R0 + 16 * wave + i) * DIN + h * 128 + 32 * ks + 8 * g);
    __syncthreads();
    f32x4 acc[8];
#pragma unroll
    for (int nf = 0; nf < 8; ++nf) {
        f32x4 s = (f32x4){0.f, 0.f, 0.f, 0.f};
        if (nf <= wave) {
#pragma unroll
            for (int ks = 0; ks < 4; ++ks) s = mfma16(qf[ks], row_frag(KT, RS, 16 * nf, 32 * ks, lane), s);
        }
#pragma unroll
        for (int r = 0; r < 4; ++r) { const int diff = (16 * wave + 4 * g + r) - (16 * nf + i);
            const float p = diff >= 0 ? s[r] * __builtin_amdgcn_exp2f(l2g * (float)diff) : 0.f;
            *(LAS unsigned short*)(PW + (4 * g + r) * RS + (16 * nf + i) * 2) = f2bf(p); }
    }
#pragma unroll
    for (int nf = 0; nf < 8; ++nf) acc[nf] = (f32x4){0.f, 0.f, 0.f, 0.f};
#pragma unroll
    for (int ks = 0; ks < 4; ++ks)
#pragma unroll
        for (int nf = 0; nf < 8; ++nf) acc[nf] = mfma16(qf[ks], tr_frag(ST, RS, 32 * ks, 16 * nf, lane), acc[nf]);
#pragma unroll
    for (int r = 0; r < 4; ++r) { const float sc = __builtin_amdgcn_exp2f(l2g * (float)(16 * wave + 4 * g + r + 1));
#pragma unroll
        for (int nf = 0; nf < 8; ++nf) acc[nf][r] *= sc; }
    asm volatile("s_waitcnt lgkmcnt(0)" ::: "memory");
#pragma unroll
    for (int ks = 0; ks < 4; ++ks) {
        if (2 * ks <= wave) { const bf16x8 pf = row_frag(PW, RS, 0, 32 * ks, lane);
#pragma unroll
            for (int nf = 0; nf < 8; ++nf) acc[nf] = mfma16(pf, tr_frag(VT, RS, 32 * ks, 16 * nf, lane), acc[nf]); }
    }
    const float* gain = a.in[14] + h * 128;
#pragma unroll
    for (int r = 0; r < 4; ++r) { float s = 0.f;
#pragma unroll
        for (int nf = 0; nf < 8; ++nf) s += acc[nf][r];
        s += __shfl_xor(s, 1); s += __shfl_xor(s, 2); s += __shfl_xor(s, 4); s += __shfl_xor(s, 8);
        const float mu = s * (1.0f / 128.0f); float q = 0.f;
#pragma unroll
        for (int nf = 0; nf < 8; ++nf) { const float d = acc[nf][r] - mu; q += d * d; }
        q += __shfl_xor(q, 1); q += __shfl_xor(q, 2); q += __shfl_xor(q, 4); q += __shfl_xor(q, 8);
        const float rstd = rsqrtf(q * (1.0f / 128.0f) + 1e-6f); const size_t row = (size_t)(R0 + 16 * wave + 4 * g + r);
#pragma unroll
        for (int nf = 0; nf < 8; ++nf) { const int e = 16 * nf + i; const float gt = bf2f(Z[row * DIN + 1536 + h * 128 + e]);
            MIX[row * 1024 + h * 128 + e] = f2bf((acc[nf][r] - mu) * rstd * gain[e] * gt); } }
    __syncthreads();
}
__device__ __forceinline__ void ret_sample_unit(const Args& a, LAS unsigned char* lds, int unit, int tid, int wave, int lane) {
    asm volatile("" : "+v"(tid), "+v"(lane));
    const bf16_t* Z = (const bf16_t*)(a.ws + WS_HZ); bf16_t* MIX = (bf16_t*)(a.ws + WS_MIX);
    const int h = unit & 3, b = unit >> 2; const int R0 = MP + b * 8; const float l2g = gamma_log2(h);
    LAS float* qs = (LAS float*)lds; LAS float* ks = qs + 1024; LAS float* vs = ks + 1024; LAS float* sc = vs + 1024; LAS float* red = sc + 64; LAS float* ob = red + 4 * 1024;
    for (int x = tid; x < 3072; x += NT) { const int which = x >> 10, t = (x >> 7) & 7, d = x & 127; qs[x] = bf2f(Z[(size_t)(R0 + t) * DIN + which * 512 + h * 128 + d]); }
    const int e = tid & 127, dq = tid >> 7;
    const float* S0 = a.in[2] + ((size_t)(b * 4 + h) * 128 + dq * 32) * 128 + e; float s0[32];
#pragma unroll
    for (int d = 0; d < 32; ++d) s0[d] = S0[(size_t)d * 128];
    __syncthreads();
    if (tid < 64) { const int t = tid >> 3, j = tid & 7; float s = 0.f; for (int d = 0; d < 128; ++d) s += qs[t * 128 + d] * ks[j * 128 + d]; sc[tid] = j <= t ? s * exp2f(l2g * (float)(t - j)) : 0.f; }
#pragma unroll
    for (int t = 0; t < 8; ++t) { float p = 0.f;
#pragma unroll
        for (int d = 0; d < 32; ++d) p += qs[t * 128 + dq * 32 + d] * s0[d];
        red[(dq * 8 + t) * 128 + e] = p * exp2f(l2g * (float)(t + 1)); }
    const float dec8 = exp2f(l2g * 8.0f); float* So = a.out + O_RETS + ((size_t)(b * 4 + h) * 128 + dq * 32) * 128 + e;
#pragma unroll
    for (int d = 0; d < 32; ++d) { float s = s0[d] * dec8;
#pragma unroll
        for (int j = 0; j < 8; ++j) s += exp2f(l2g * (float)(7 - j)) * ks[j * 128 + dq * 32 + d] * vs[j * 128 + e];
        So[(size_t)d * 128] = s; }
    __syncthreads();
    { const int t = tid >> 6;
        float o0 = 0.f, o1 = 0.f;
#pragma unroll
        for (int q = 0; q < 4; ++q) { o0 += red[(q * 8 + t) * 128 + lane]; o1 += red[(q * 8 + t) * 128 + lane + 64]; }
        for (int j = 0; j <= t; ++j) { const float w = sc[t * 8 + j]; o0 += w * vs[j * 128 + lane]; o1 += w * vs[j * 128 + lane + 64]; }
        const float mu = wave_sum(o0 + o1) * (1.0f / 128.0f); const float d0 = o0 - mu, d1 = o1 - mu; const float rstd = rsqrtf(wave_sum(d0 * d0 + d1 * d1) * (1.0f / 128.0f) + 1e-6f);
        const size_t row = (size_t)(R0 + t); const float* gain = a.in[14] + h * 128;
        MIX[row * 1024 + h * 128 + lane] = f2bf(d0 * rstd * gain[lane] * bf2f(Z[row * DIN + 1536 + h * 128 + lane]));
        MIX[row * 1024 + h * 128 + lane + 64] = f2bf(d1 * rstd * gain[lane + 64] * bf2f(Z[row * DIN + 1536 + h * 128 + lane + 64])); }
    __syncthreads();
}
__device__ __forceinline__ void lru_seg_unit(const Args& a, LAS unsigned char* lds, int seg, int tid, int wave, int lane) {
    asm volatile("" : "+v"(tid), "+v"(lane));
    const bf16_t* Z = (const bf16_t*)(a.ws + WS_HZ); const bf16_t* LW = (const bf16_t*)(a.ws + WS_LRUW);
    float* HLOC = (float*)(a.ws + WS_HLOC); float* PCUM = (float*)(a.ws + WS_PCUM); float* SEGP = (float*)(a.ws + WS_SEG); float* SEGH = SEGP + 128 * 512;
    const int R0 = seg * 128; const bool sample = R0 >= MP; const int i = lane & 15, g = lane >> 4; const int cb = wave * 64;
    LAS unsigned char* WF = lds + wave * 16384;
#pragma unroll
    for (int w2 = 0; w2 < 2; ++w2)
#pragma unroll
        for (int nf = 0; nf < 4; ++nf)
#pragma unroll
            for (int ks = 0; ks < 2; ++ks) *(LAS u32x4*)(WF + ((w2 * 4 + nf) * 2 + ks) * 1024 + lane * 16) = *(const u32x4*)(LW + w2 * 32768 + ((size_t)(wave * 64 + 16 * nf + i)) * 64 + 32 * ks + 8 * g);
    float ba[4], bx[4], sp8[4];
#pragma unroll
    for (int nf = 0; nf < 4; ++nf) { const int ch = cb + 16 * nf + i; ba[nf] = a.in[18][ch]; bx[nf] = a.in[20][ch]; const float l = -a.in[21][ch];
        sp8[nf] = 8.0f * ((l > 0.f ? l : 0.f) + log1pf(expf(-fabsf(l)))); }
    float prun[4], hrun[4];
#pragma unroll
    for (int nf = 0; nf < 4; ++nf) { prun[nf] = 1.0f; hrun[nf] = 0.f; }
    asm volatile("s_waitcnt lgkmcnt(0)" ::: "memory");
#pragma unroll 1
    for (int st = 0; st < 8; ++st) {
        const int row = R0 + 16 * st + i; const int t = sample ? (row & 7) : (row & 2047);
        int lo = 0; asm volatile("" : "+v"(lo));
        bf16x8 xa[2];
#pragma unroll
        for (int ks = 0; ks < 2; ++ks) { const int ch0 = cb + 32 * ks + 8 * g; float xc[8];
            { const f32x4 b0 = *(const f32x4*)(a.in[16] + lo + ch0), b1 = *(const f32x4*)(a.in[16] + lo + ch0 + 4); xc[0] = b0[0]; xc[1] = b0[1]; xc[2] = b0[2]; xc[3] = b0[3]; xc[4] = b1[0]; xc[5] = b1[1]; xc[6] = b1[2]; xc[7] = b1[3]; }
#pragma unroll
            for (int j = 0; j < 4; ++j) { const int tt = t - 3 + j; float u[8];
                const f32x4 cw0 = *(const f32x4*)(a.in[15] + lo + j * 512 + ch0), cw1 = *(const f32x4*)(a.in[15] + lo + j * 512 + ch0 + 4);
                const float cwv[8] = {cw0[0], cw0[1], cw0[2], cw0[3], cw1[0], cw1[1], cw1[2], cw1[3]};
                if (tt >= 0) { const u32x4 v = *(const u32x4*)(Z + (size_t)(row - 3 + j) * DIN + 2048 + ch0);
                    u[0] = bflo(v.x); u[1] = bfhi(v.x); u[2] = bflo(v.y); u[3] = bfhi(v.y); u[4] = bflo(v.z); u[5] = bfhi(v.z); u[6] = bflo(v.w); u[7] = bfhi(v.w); }
                else if (sample) { const float* cs = a.in[4] + ((size_t)((row - MP) >> 3) * 3 + (tt + 3)) * 512 + ch0; const f32x4 v0 = *(const f32x4*)cs, v1 = *(const f32x4*)(cs + 4);
                    u[0] = v0[0]; u[1] = v0[1]; u[2] = v0[2]; u[3] = v0[3]; u[4] = v1[0]; u[5] = v1[1]; u[6] = v1[2]; u[7] = v1[3]; }
                else {
#pragma unroll
                    for (int jj = 0; jj < 8; ++jj) u[jj] = 0.f; }
#pragma unroll
                for (int jj = 0; jj < 8; ++jj) xc[jj] += cwv[jj] * u[jj]; }
            u32x4 w; w.x = cvt_pk_bf16(xc[0], xc[1]); w.y = cvt_pk_bf16(xc[2], xc[3]); w.z = cvt_pk_bf16(xc[4], xc[5]); w.w = cvt_pk_bf16(xc[6], xc[7]);
            xa[ks] = __builtin_bit_cast(bf16x8, w); }
#pragma unroll
        for (int nf = 0; nf < 4; ++nf) {
            f32x4 ra = (f32x4){0.f, 0.f, 0.f, 0.f}, rx = (f32x4){0.f, 0.f, 0.f, 0.f}, xv = (f32x4){0.f, 0.f, 0.f, 0.f};
#pragma unroll
            for (int ks = 0; ks < 2; ++ks) {
                ra = mfma16(xa[ks], *(LAS const bf16x8*)(WF + ((0 * 4 + nf) * 2 + ks) * 1024 + lane * 16), ra);
                rx = mfma16(xa[ks], *(LAS const bf16x8*)(WF + ((1 * 4 + nf) * 2 + ks) * 1024 + lane * 16), rx);
                bf16x8 idf;
#pragma unroll
                for (int jj = 0; jj < 8; ++jj) idf[jj] = (32 * ks + 8 * g + jj == 16 * nf + i) ? (short)0x3F80 : (short)0;
                xv = mfma16(xa[ks], idf, xv); }
            float al[4], hl[4]; float p = 1.0f, hh = 0.f;
#pragma unroll
            for (int r = 0; r < 4; ++r) {
                const float rr = pg8::fast_sigmoid(ra[r] + ba[nf]), ii = pg8::fast_sigmoid(rx[r] + bx[nf]);
                const float la = -rr * sp8[nf]; const float av = __builtin_amdgcn_exp2f(la * pg8::LOG2E);
                const float y = 2.0f * la; const float em1 = (y > -0.25f) ? y * (1.0f + y * (0.5f + y * (0.16666667f + y * (0.041666668f + y * (0.0083333338f + y * 0.0013888889f))))) : __builtin_amdgcn_exp2f(y * pg8::LOG2E) - 1.0f;
                const float gx = sqrtf(-em1) * (ii * xv[r]);
                hh = av * hh + gx; p *= av; al[r] = p; hl[r] = hh; }
            const float PG = al[3], HG = hl[3];
            const float p0 = __shfl(PG, i), h0 = __shfl(HG, i), p1 = __shfl(PG, 16 + i), h1 = __shfl(HG, 16 + i), p2 = __shfl(PG, 32 + i), h2 = __shfl(HG, 32 + i);
            float pin, hin;
            if (!sample) { pin = prun[nf]; hin = hrun[nf];
                if (g > 0) { hin = h0 + p0 * hin; pin = p0 * pin; }
                if (g > 1) { hin = h1 + p1 * hin; pin = p1 * pin; }
                if (g > 2) { hin = h2 + p2 * hin; pin = p2 * pin; } }
            else { pin = (g == 1) ? p0 : ((g == 3) ? p2 : 1.0f); hin = (g == 1) ? h0 : ((g == 3) ? h2 : 0.f); }
#pragma unroll
            for (int r = 0; r < 4; ++r) { const size_t o = (size_t)(R0 + 16 * st + 4 * g + r) * 512 + cb + 16 * nf + i; HLOC[o] = hl[r] + al[r] * hin; PCUM[o] = al[r] * pin; }
            const float pe = al[3] * pin, he = hl[3] + al[3] * hin;
            prun[nf] = __shfl(pe, 48 + i); hrun[nf] = __shfl(he, 48 + i);
        }
    }
    if (!sample && g == 0) {
#pragma unroll
        for (int nf = 0; nf < 4; ++nf) { SEGP[(size_t)seg * 512 + cb + 16 * nf + i] = prun[nf]; SEGH[(size_t)seg * 512 + cb + 16 * nf + i] = hrun[nf]; } }
}
__device__ __forceinline__ void lru_scan(const Args& a, int gthread) {
    if (gthread >= 8 * 512) return; const int ch = gthread & 511, b = gthread >> 9;
    const float* SEGP = (const float*)(a.ws + WS_SEG); const float* SEGH = SEGP + 128 * 512; float* HIN = (float*)(a.ws + WS_SEG) + 2 * 128 * 512; float h = 0.f;
    for (int s = 0; s < 16; ++s) { const size_t o = (size_t)(b * 16 + s) * 512 + ch; HIN[o] = h; h = SEGH[o] + SEGP[o] * h; }
}
__device__ __forceinline__ void lru_out_row(const Args& a, int row, int lane) {
    asm volatile("" : "+v"(lane));
    const bf16_t* Z = (const bf16_t*)(a.ws + WS_HZ); bf16_t* MIX = (bf16_t*)(a.ws + WS_MIX);
    const float* HLOC = (const float*)(a.ws + WS_HLOC) + (size_t)row * 512 + 8 * lane; const float* PCUM = (const float*)(a.ws + WS_PCUM) + (size_t)row * 512 + 8 * lane;
    const bool sample = row >= MP; const int t = sample ? (row & 7) : (row & 2047); const int T = sample ? 8 : 2048;
    const float* hinp = sample ? a.in[3] + (size_t)((row - MP) >> 3) * 512 + 8 * lane : (const float*)(a.ws + WS_SEG) + 2 * 128 * 512 + (size_t)(row >> 7) * 512 + 8 * lane;
    float hs[8]; float ss = 0.f;
#pragma unroll
    for (int q = 0; q < 2; ++q) { const f32x4 hl = *(const f32x4*)(HLOC + 4 * q), pc = *(const f32x4*)(PCUM + 4 * q), hi = *(const f32x4*)(hinp + 4 * q);
#pragma unroll
        for (int e = 0; e < 4; ++e) { const float v = hl[e] + pc[e] * hi[e]; hs[4 * q + e] = v; ss += v * v; } }
    const float rstd = rsqrtf(wave_sum(ss) * (1.0f / 512.0f) + 1e-6f);
    const u32x4 gv = *(const u32x4*)(Z + (size_t)row * DIN + 2560 + 8 * lane); const float* gain = a.in[22] + 8 * lane;
    float gt[8] = {bflo(gv.x), bfhi(gv.x), bflo(gv.y), bfhi(gv.y), bflo(gv.z), bfhi(gv.z), bflo(gv.w), bfhi(gv.w)}; float o[8];
#pragma unroll
    for (int e = 0; e < 8; ++e) o[e] = hs[e] * rstd * gain[e] * gt[e];
    u32x4 w; w.x = cvt_pk_bf16(o[0], o[1]); w.y = cvt_pk_bf16(o[2], o[3]); w.z = cvt_pk_bf16(o[4], o[5]); w.w = cvt_pk_bf16(o[6], o[7]);
    *(u32x4*)(MIX + (size_t)row * 1024 + 512 + 8 * lane) = w;
    if (t == T - 1) { float* oh = sample ? a.out + O_HS + (size_t)((row - MP) >> 3) * 512 + 8 * lane : a.out + O_HP + (size_t)(row >> 11) * 512 + 8 * lane;
        *(f32x4*)oh = (f32x4){hs[0], hs[1], hs[2], hs[3]}; *(f32x4*)(oh + 4) = (f32x4){hs[4], hs[5], hs[6], hs[7]}; }
}
}

namespace mk {
constexpr int RSA = 288;
constexpr int ATILE = 256 * RSA;
__device__ __forceinline__ bf16x8 tr_frag_acc(LAS const unsigned char* T, int RSb, int r0, int c0, int lane) {
    const int g = lane >> 4, q = (lane & 15) >> 2, p = lane & 3;
    LAS const unsigned char* a = T + (r0 + 4 * g + q) * RSb + (c0 + 4 * p) * 2;
    const v4i16_t lo = __builtin_amdgcn_ds_read_tr16_b64_v4i16((LAS v4i16_t*)a);
    const v4i16_t hi = __builtin_amdgcn_ds_read_tr16_b64_v4i16((LAS v4i16_t*)(a + 16 * RSb));
    return (bf16x8){lo[0], lo[1], lo[2], lo[3], hi[0], hi[1], hi[2], hi[3]};
}
__device__ __forceinline__ bf16x8 pack8(const f32x4& a, const f32x4& b) { u32x4 w; w.x = cvt_pk_bf16(a[0], a[1]); w.y = cvt_pk_bf16(a[2], a[3]); w.z = cvt_pk_bf16(b[0], b[1]); w.w = cvt_pk_bf16(b[2], b[3]); return __builtin_bit_cast(bf16x8, w); }

struct AttnStage { u32x4 r[8]; };
__device__ __forceinline__ void attn_issue(AttnStage& s, const bf16_t* src, int tid) {
#pragma unroll
    for (int x = 0; x < 8; ++x) { const int q = tid + NT * x, r = q >> 4, ch = q & 15; s.r[x] = *(const u32x4*)(src + (size_t)r * 1024 + ch * 8); }
}
__device__ __forceinline__ void attn_commit(const AttnStage& s, LAS unsigned char* T, int tid) {
#pragma unroll
    for (int x = 0; x < 8; ++x) { const int q = tid + NT * x, r = q >> 4, ch = q & 15; *(LAS u32x4*)(T + r * RSA + ch * 16) = s.r[x]; }
}
__device__ __forceinline__ void xattn_prompt_units(const Args& a, LAS unsigned char* lds, int first, int step, int tid, int wave, int lane) {
    asm volatile("" : "+v"(tid), "+v"(lane));
    const bf16_t* QX = (const bf16_t*)(a.ws + WS_QX); const bf16_t* KM = (const bf16_t*)(a.ws + WS_KM); const bf16_t* VM = (const bf16_t*)(a.ws + WS_VM); bf16_t* AO = (bf16_t*)(a.ws + WS_AO);
    const int i = lane & 15, g = lane >> 4;
    LAS unsigned char* B0 = lds; LAS unsigned char* B1 = lds + ATILE;
    if (first >= 512) return;
    AttnStage st;
#define MK_SRC(u, s) ((((s) < 2) ? KM : VM) + (size_t)(((u) >> 2) * 128 >> 11) * 256 * 1024 + ((u) & 3) * 256 + ((s) & 1) * 128)
    attn_issue(st, MK_SRC(first, 0), tid); attn_commit(st, B0, tid);
    attn_issue(st, MK_SRC(first, 1), tid); attn_commit(st, B1, tid);
    __syncthreads();
    for (int u = first; u < 512; u += step) {
        const int h = u & 3, R0 = (u >> 2) * 128; const bool more = (u + step) < 512;
        bf16x8 qf[8];
#pragma unroll
        for (int ks = 0; ks < 8; ++ks) qf[ks] = *(const bf16x8*)(QX + (size_t)(R0 + 16 * wave + i) * 1024 + h * 256 + 32 * ks + 8 * g);
        f32x4 s[16];
#pragma unroll
        for (int nf = 0; nf < 16; ++nf) s[nf] = (f32x4){0.f, 0.f, 0.f, 0.f};
        attn_issue(st, MK_SRC(u, 2), tid);
#pragma unroll
        for (int kk = 0; kk < 4; ++kk)
#pragma unroll
            for (int nf = 0; nf < 16; ++nf) s[nf] = mfma16(row_frag(B0, RSA, 16 * nf, 32 * kk, lane), qf[kk], s[nf]);
        __syncthreads(); attn_commit(st, B0, tid);
        attn_issue(st, MK_SRC(u, 3), tid);
#pragma unroll
        for (int kk = 0; kk < 4; ++kk)
#pragma unroll
            for (int nf = 0; nf < 16; ++nf) s[nf] = mfma16(row_frag(B1, RSA, 16 * nf, 32 * kk, lane), qf[4 + kk], s[nf]);
        float m = s[0][0];
#pragma unroll
        for (int nf = 0; nf < 16; ++nf)
#pragma unroll
            for (int r = 0; r < 4; ++r) m = fmaxf(m, s[nf][r]);
        m = fmaxf(m, __shfl_xor(m, 16)); m = fmaxf(m, __shfl_xor(m, 32));
        float l = 0.f;
#pragma unroll
        for (int nf = 0; nf < 16; ++nf)
#pragma unroll
            for (int r = 0; r < 4; ++r) { const float p = __builtin_amdgcn_exp2f(s[nf][r] - m); s[nf][r] = p; l += p; }
        l += __shfl_xor(l, 16); l += __shfl_xor(l, 32);
        const float inv = 1.0f / l;
        bf16x8 pf[8];
#pragma unroll
        for (int ks = 0; ks < 8; ++ks) pf[ks] = pack8(s[2 * ks], s[2 * ks + 1]);
        __syncthreads(); attn_commit(st, B1, tid);
        __syncthreads();
        if (more) attn_issue(st, MK_SRC(u + step, 0), tid);
        bf16_t* orow = AO + (size_t)(R0 + 16 * wave + i) * 1024 + h * 256 + 4 * g;
#pragma unroll
        for (int eh = 0; eh < 2; ++eh) {
            LAS unsigned char* T = eh ? B1 : B0;
            f32x4 o[8];
#pragma unroll
            for (int nf = 0; nf < 8; ++nf) o[nf] = (f32x4){0.f, 0.f, 0.f, 0.f};
#pragma unroll
            for (int ks = 0; ks < 8; ++ks)
#pragma unroll
                for (int nf = 0; nf < 8; ++nf) o[nf] = mfma16(tr_frag_acc(T, RSA, 32 * ks, 16 * nf, lane), pf[ks], o[nf]);
#pragma unroll
            for (int nf = 0; nf < 8; ++nf) { u32x2 w; w.x = cvt_pk_bf16(o[nf][0] * inv, o[nf][1] * inv); w.y = cvt_pk_bf16(o[nf][2] * inv, o[nf][3] * inv); *(u32x2*)(orow + eh * 128 + 16 * nf) = w; }
            if (eh == 0) { __syncthreads(); if (more) { attn_commit(st, B0, tid); attn_issue(st, MK_SRC(u + step, 1), tid); } }
        }
        __syncthreads(); if (more) attn_commit(st, B1, tid);
        __syncthreads();
    }
#undef MK_SRC
}
__device__ __forceinline__ void xattn_sample_unit(const Args& a, LAS unsigned char* lds, int unit, int tid, int wave, int lane) {
    asm volatile("" : "+v"(tid), "+v"(lane));
    const bf16_t* QX = (const bf16_t*)(a.ws + WS_QX); bf16_t* AO = (bf16_t*)(a.ws + WS_AO);
    const int h = unit & 3, b = unit >> 2; const int R0 = MP + b * 8; const int i = lane & 15, g = lane >> 4;
    const float* Kc = a.in[5] + (size_t)b * 256 * 1024 + h * 256; const float* Vc = a.in[6] + (size_t)b * 256 * 1024 + h * 256 + 4 * lane;
    LAS float* SC = (LAS float*)lds;
    LAS float* RED = SC + 2048;
    bf16x8 qf[8];
#pragma unroll
    for (int ks = 0; ks < 8; ++ks) { qf[ks] = *(const bf16x8*)(QX + (size_t)(R0 + (i & 7)) * 1024 + h * 256 + 32 * ks + 8 * g); }
#pragma unroll
    for (int nf = 0; nf < 2; ++nf) {
        const float* kr = Kc + (size_t)(32 * wave + 16 * nf + i) * 1024 + 8 * g; f32x4 kv[8][2];
#pragma unroll
        for (int ks = 0; ks < 8; ++ks) { kv[ks][0] = __builtin_nontemporal_load((const f32x4*)(kr + 32 * ks)); kv[ks][1] = __builtin_nontemporal_load((const f32x4*)(kr + 32 * ks + 4)); }
        f32x4 sc = (f32x4){0.f, 0.f, 0.f, 0.f};
#pragma unroll
        for (int ks = 0; ks < 8; ++ks) sc = mfma16(qf[ks], pack8(kv[ks][0], kv[ks][1]), sc);
        if (g < 2) {
#pragma unroll
            for (int r = 0; r < 4; ++r) SC[(4 * g + r) * 256 + 32 * wave + 16 * nf + i] = sc[r]; }
    }
    __syncthreads();
    { const int t = wave; f32x4 v = *(LAS const f32x4*)(SC + t * 256 + 4 * lane); float m = fmaxf(fmaxf(v[0], v[1]), fmaxf(v[2], v[3]));
#pragma unroll
        for (int o = 1; o < 64; o <<= 1) m = fmaxf(m, __shfl_xor(m, o));
        f32x4 p; float l = 0.f;
#pragma unroll
        for (int e = 0; e < 4; ++e) { p[e] = __builtin_amdgcn_exp2f(v[e] - m); l += p[e]; }
        l = 1.0f / wave_sum(l); *(LAS f32x4*)(SC + t * 256 + 4 * lane) = p * l; }
    __syncthreads();
    float o[8][4];
#pragma unroll
    for (int t = 0; t < 8; ++t)
#pragma unroll
        for (int e = 0; e < 4; ++e) o[t][e] = 0.f;
#pragma unroll 1
    for (int k8 = 0; k8 < 4; ++k8) { f32x4 vv[8];
#pragma unroll
        for (int kk = 0; kk < 8; ++kk) vv[kk] = __builtin_nontemporal_load((const f32x4*)(Vc + (size_t)(32 * wave + 8 * k8 + kk) * 1024));
#pragma unroll
        for (int kk = 0; kk < 8; ++kk) { const int key = 32 * wave + 8 * k8 + kk;
#pragma unroll
            for (int t = 0; t < 8; ++t) { const float p = SC[t * 256 + key];
#pragma unroll
                for (int e = 0; e < 4; ++e) o[t][e] += p * vv[kk][e]; } } }
#pragma unroll
    for (int t = 0; t < 8; ++t) *(LAS f32x4*)(RED + (wave * 8 + t) * 256 + 4 * lane) = (f32x4){o[t][0], o[t][1], o[t][2], o[t][3]};
    __syncthreads();
    { const int t = tid >> 6, d = 4 * lane; f32x4 acc = (f32x4){0.f, 0.f, 0.f, 0.f};
#pragma unroll
        for (int w = 0; w < 8; ++w) acc += *(LAS const f32x4*)(RED + (w * 8 + t) * 256 + d);
        u32x2 wv; wv.x = cvt_pk_bf16(acc[0], acc[1]); wv.y = cvt_pk_bf16(acc[2], acc[3]); *(u32x2*)(AO + (size_t)(R0 + t) * 1024 + h * 256 + d) = wv; }
    __syncthreads();
}
}

namespace mk {
constexpr int LDS_BYTES = 163840, MISC_OFF = LDS_BYTES - 256;
#ifndef MK_PHASE_HI
#define MK_PHASE_HI 99
#endif
__global__ void __launch_bounds__(NT, 2) mega_fwd(Args a) {
    extern __shared__ __attribute__((aligned(16))) unsigned char lds_raw[];
    LAS unsigned char* lds = (LAS unsigned char*)lds_raw;
    volatile LAS unsigned* MISC = (volatile LAS unsigned*)(lds + MISC_OFF);
    const int tid = threadIdx.x, lane = tid & 63, wave = __builtin_amdgcn_readfirstlane(tid >> 6);
    const int G = gridDim.x, bx = blockIdx.x; const int vcu = (G % 8 == 0) ? (bx % 8) * (G / 8) + bx / 8 : bx;
    if (tid < 64) MISC[tid] = 0u;
    __syncthreads();
    unsigned char* ws = a.ws;
    XcdBarrier bar = xcd_barrier_post((unsigned*)((gu32*)(ws + WS_CTL) + CW_BAR), MISC + 8);
    float* Y = a.out + O_Y;
    bf16_t* XB = (bf16_t*)(ws + WS_XB); bf16_t* HB = (bf16_t*)(ws + WS_HZ); bf16_t* MIX = (bf16_t*)(ws + WS_MIX);
    float* ssq0 = (float*)(ws + WS_SSQ); float* ssq1 = (float*)(ws + WS_SSQ + SSQ_STRIDE); float* ssq2 = (float*)(ws + WS_SSQ + 2 * SSQ_STRIDE); float* ssq3 = (float*)(ws + WS_SSQ + 3 * SSQ_STRIDE); float* ssq4 = (float*)(ws + WS_SSQ + 4 * SSQ_STRIDE);
    const int gw = vcu * NW + wave, NGW = G * NW;
#define PHASE(k) if ((k) <= MK_PHASE_HI)
#define GRID_BAR() xcd_barrier(bar)
#ifdef MK_REP_P0
    PHASE(0) { p0_prologue(a, lds, vcu, G, wave, lane); }
    GRID_BAR();
#endif
    PHASE(0) { p0_prologue(a, lds, vcu, G, wave, lane); }
    GRID_BAR();
    PHASE(1) { pg8::Gemm g{XB, (const bf16_t*)(ws + W_UP1), M, 2 * FF, D}; pg8::StaticOrder S; S.init(M, 2 * FF, G, bx); pg8::EpiSwiglu E{HB, FF, ssq0};
        pg8::gemm_phase<pg8::EpiSwiglu, pg8::StaticOrder, true, true>(lds, g, S, E); }
    GRID_BAR();
    PHASE(2) { pg8::Gemm g{HB, (const bf16_t*)(ws + W_DN1), M, D, FF}; pg8::StaticOrder S; S.init(M, D, G, bx); pg8::EpiResid E{a.in[0], a.in[1], Y, XB, ssq1, 0.5f};
        pg8::gemm_phase<pg8::EpiResid, pg8::StaticOrder, true, true>(lds, g, S, E); }
    GRID_BAR();
    PHASE(3) { pg8::Gemm g{XB, (const bf16_t*)(ws + W_IN), M, DIN, D}; pg8::StaticOrder S; S.init(M, DIN, G, bx);
        pg8::EpiWin E{HB, ssq1, (const float*)(ws + WS_ROPE), (const float*)(ws + WS_ROPE) + 2056 * 64, a.out + O_CONVP, a.out + O_CONVS};
        pg8::gemm_phase<pg8::EpiWin, pg8::StaticOrder, true, true>(lds, g, S, E); }
    GRID_BAR();
#ifdef MK_REP_P4
    PHASE(4) { for (int u = vcu; u < 136 + 512 + 512; u += G) { if (u < 136) { lru_seg_unit(a, lds, u, tid, wave, lane); __syncthreads(); } else if (u < 648) ret_u_unit(a, lds, u - 136, tid, wave, lane); else ret_sample_unit(a, lds, u - 648, tid, wave, lane); } }
    GRID_BAR();
    PHASE(5) { int tid5 = tid; asm volatile("" : "+v"(tid5)); for (int t = bx * NT + tid5; t < 32 * 4096; t += G * NT) ret_scan(a, t); lru_scan(a, bx * NT + tid5); }
    GRID_BAR();
    PHASE(6) { for (int u = vcu; u < 512; u += G) ret_out_unit(a, lds, u, tid, wave, lane); for (int r = gw; r < M; r += NGW) lru_out_row(a, r, lane); }
    GRID_BAR();
#endif
    PHASE(4) { for (int u = vcu; u < 136 + 512 + 512; u += G) { if (u < 136) { lru_seg_unit(a, lds, u, tid, wave, lane); __syncthreads(); } else if (u < 648) ret_u_unit(a, lds, u - 136, tid, wave, lane); else ret_sample_unit(a, lds, u - 648, tid, wave, lane); } }
    GRID_BAR();
    PHASE(5) { int tid5 = tid; asm volatile("" : "+v"(tid5)); for (int t = bx * NT + tid5; t < 32 * 4096; t += G * NT) ret_scan(a, t); lru_scan(a, bx * NT + tid5); }
    GRID_BAR();
    PHASE(6) { for (int u = vcu; u < 512; u += G) ret_out_unit(a, lds, u, tid, wave, lane); for (int r = gw; r < M; r += NGW) lru_out_row(a, r, lane); }
    GRID_BAR();
    PHASE(7) { { pg8::Gemm g{MIX, (const bf16_t*)(ws + W_OUT), M, D, D}; pg8::StaticOrder S; S.init(M, D, G, bx); pg8::EpiResid E{Y, Y + (size_t)MP * D, Y, XB, ssq2, 1.0f};
          pg8::gemm_phase<pg8::EpiResid, pg8::StaticOrder, true, true>(lds, g, S, E); }
        { pg8::Gemm g{(const bf16_t*)(ws + WS_MEMB), (const bf16_t*)(ws + W_KV), 2048, 2048, D}; pg8::StaticOrder S; S.init(2048, 2048, G, (bx + G - 16) % G);
          pg8::EpiKV E{a.out + O_MK, a.out + O_MV, (bf16_t*)(ws + WS_KM), (bf16_t*)(ws + WS_VM)};
          pg8::gemm_phase<pg8::EpiKV, pg8::StaticOrder, true, true>(lds, g, S, E); } }
    GRID_BAR();
    PHASE(8) { pg8::Gemm g{XB, (const bf16_t*)(ws + W_Q), M, D, D}; pg8::StaticOrder S; S.init(M, D, G, bx); pg8::EpiQ E{(bf16_t*)(ws + WS_QX), ssq2, QSCALE};
        pg8::gemm_phase<pg8::EpiQ, pg8::StaticOrder, true, true>(lds, g, S, E); }
    GRID_BAR();
#ifdef MK_REP_P7
    PHASE(9) { gu32* qhead = (gu32*)(ws + WS_CTL) + CW_QUEUE;
        const int half = G / 2, pslot = (bx & 7) * (half / 8) + (bx >> 4);
        if (((bx >> 3) & 1) == 0) xattn_prompt_units(a, lds, pslot, half, tid, wave, lane);
        for (;;) { if (tid == 0) MISC[16] = __hip_atomic_fetch_add(qhead, 1u, __ATOMIC_RELAXED, __HIP_MEMORY_SCOPE_AGENT); __syncthreads(); const int u = (int)MISC[16]; __syncthreads(); if (u >= 512) break; xattn_sample_unit(a, lds, u, tid, wave, lane); } }
    GRID_BAR();
#endif
    PHASE(9) { gu32* qhead = (gu32*)(ws + WS_CTL) + CW_QUEUE;
        const int half = G / 2, pslot = (bx & 7) * (half / 8) + (bx >> 4);
        if (((bx >> 3) & 1) == 0) xattn_prompt_units(a, lds, pslot, half, tid, wave, lane);
        for (;;) { if (tid == 0) MISC[16] = __hip_atomic_fetch_add(qhead, 1u, __ATOMIC_RELAXED, __HIP_MEMORY_SCOPE_AGENT); __syncthreads(); const int u = (int)MISC[16]; __syncthreads(); if (u >= 512) break; xattn_sample_unit(a, lds, u, tid, wave, lane); } }
    GRID_BAR();
    PHASE(10) { pg8::Gemm g{(const bf16_t*)(ws + WS_AO), (const bf16_t*)(ws + W_O), M, D, D}; pg8::StaticOrder S; S.init(M, D, G, bx); pg8::EpiResid E{Y, Y + (size_t)MP * D, Y, XB, ssq3, 1.0f};
        pg8::gemm_phase<pg8::EpiResid, pg8::StaticOrder, true, true>(lds, g, S, E); }
    GRID_BAR();
    PHASE(11) { pg8::Gemm g{XB, (const bf16_t*)(ws + W_UP2), M, 2 * FF, D}; pg8::StaticOrder S; S.init(M, 2 * FF, G, bx); pg8::EpiSwiglu E{HB, FF, ssq3};
        pg8::gemm_phase<pg8::EpiSwiglu, pg8::StaticOrder, true, true>(lds, g, S, E); }
    GRID_BAR();
    PHASE(12) { pg8::Gemm g{HB, (const bf16_t*)(ws + W_DN2), M, D, FF}; pg8::StaticOrder S; S.init(M, D, G, bx); pg8::EpiResid E{Y, Y + (size_t)MP * D, Y, nullptr, ssq4, 0.5f};
        pg8::gemm_phase<pg8::EpiResid, pg8::StaticOrder, true, true>(lds, g, S, E); }
    GRID_BAR();
    PHASE(13) { int lane13 = lane; asm volatile("" : "+v"(lane13)); for (int r = gw; r < M; r += NGW) { GAS f32x4* yr = (GAS f32x4*)(Y + (size_t)r * D) + lane13; const GAS f32x4* gn = (const GAS f32x4*)a.in[33] + lane13; const float rs = rsqrtf(ssq4[r] * (1.0f / 1024.0f) + 1e-6f);
#pragma unroll
            for (int j = 0; j < 4; ++j) yr[64 * j] = yr[64 * j] * rs * gn[64 * j]; } }
}
}

static int mk_launch(void* const* d_in, int n_in, void* d_out, void* d_ws, size_t ws_size, hipStream_t stream) {
    static int grid = 0;
    if (grid == 0) {
        int dev = 0, cus = 0, per_cu = 0;
        if (n_in != 34 || ws_size < mk::WS_END) { fprintf(stderr, "kernel_launch: n_in %d ws %zu unexpected\n", n_in, ws_size); grid = -1; return -1; }
        if (hipGetDevice(&dev) != hipSuccess || hipDeviceGetAttribute(&cus, hipDeviceAttributeMultiprocessorCount, dev) != hipSuccess) { grid = -1; return -1; }
        if (hipFuncSetAttribute((const void*)mk::mega_fwd, hipFuncAttributeMaxDynamicSharedMemorySize, mk::LDS_BYTES) != hipSuccess) { fprintf(stderr, "kernel_launch: hipFuncSetAttribute failed\n"); grid = -1; return -1; }
        if (hipOccupancyMaxActiveBlocksPerMultiprocessor(&per_cu, (const void*)mk::mega_fwd, mk::NT, mk::LDS_BYTES) != hipSuccess || per_cu < 1) { fprintf(stderr, "kernel_launch: occupancy query reports %d blocks per CU\n", per_cu); grid = -1; (void)hipGetLastError(); return -1; }
        grid = cus;
    }
    if (grid < 0) return -1;
    (void)hipMemsetAsync((char*)d_ws + mk::WS_CTL, 0, mk::CTL_ZERO_BYTES, stream);
    mk::Args a{};
    for (int i = 0; i < 34; ++i) a.in[i] = (const float*)d_in[i];
    a.out = (float*)d_out; a.ws = (unsigned char*)d_ws;
    hipLaunchKernelGGL(mk::mega_fwd, dim3(grid), dim3(mk::NT), mk::LDS_BYTES, stream, a);
    return 0;
}

extern "C" void kernel_launch(void* const* d_in, const int* in_sizes, int n_in, void* d_out, int out_size, void* d_ws, size_t ws_size, hipStream_t stream) {
    (void)in_sizes; (void)out_size; mk_launch(d_in, n_in, d_out, d_ws, ws_size, stream);
}
```
